# Optimizing an MI355X kernel written in HIP

```python
import math
import jax, jax.numpy as jnp
from jax import lax
import numpy as np

D_MODEL = 1024
BATCH = 4
SEQ = 4096
DEPTH = 1

MEM_LEN = 256
POOL_WINDOWS = (2, 4, 8, 16)
POOL_GROUPS = 4
POOL_GROUP_DIM = D_MODEL // 8
POOL_DIM = POOL_GROUPS * POOL_GROUP_DIM
MLA_HEADS = 8
QK_NOPE_DIM = 128
QK_ROPE_DIM = 64
V_HEAD_DIM = 128
Q_LORA_RANK = 384
KV_LORA_RANK = 256
MLA_V_DIM = MLA_HEADS * V_HEAD_DIM
ROPE_THETA = 10000.0
Q_BLOCK = 128
XATTN_HEADS = 4
XATTN_HEAD_DIM = 128
XATTN_DIM = XATTN_HEADS * XATTN_HEAD_DIM
N_BRANCHES = 3
IN_SPLIT_SIZES = (POOL_DIM, Q_LORA_RANK, KV_LORA_RANK, QK_ROPE_DIM, XATTN_DIM, N_BRANCHES * D_MODEL)
D_IN = sum(IN_SPLIT_SIZES)
N_GROUPS = 4
EXPERTS_PER_GROUP = 8
N_EXPERTS = N_GROUPS * EXPERTS_PER_GROUP
TOP_K = 2
D_EXPERT = D_MODEL // 4
MOE_BLOCK = 128
RMS_EPS = 1e-6
NEG_INF = -1e30

kernel_name = "hybrid_pool_mla_memxattn_hmoe"


def rms_norm(x, g):
    xf = x.astype(jnp.float32)
    xf = xf * lax.rsqrt(jnp.mean(xf * xf, axis=-1, keepdims=True) + RMS_EPS)
    return xf.astype(x.dtype) * g


def rope_tables(positions):
    inv_freq = 1.0 / (ROPE_THETA ** (jnp.arange(0, QK_ROPE_DIM, 2, dtype=jnp.float32) / QK_ROPE_DIM))
    ang = positions.astype(jnp.float32)[..., None] * inv_freq
    return jnp.cos(ang), jnp.sin(ang)


def apply_rope(x, cos, sin):
    xf = x.astype(jnp.float32)
    half = xf.shape[-1] // 2
    x1, x2 = xf[..., :half], xf[..., half:]
    return jnp.concatenate([x1 * cos - x2 * sin, x2 * cos + x1 * sin], axis=-1).astype(x.dtype)


def pool_mixer(u, pool_w, pool_scale):
    B, S, _ = u.shape
    uf = u.astype(jnp.float32)
    cs = jnp.pad(jnp.cumsum(uf, axis=1), ((0, 0), (1, 0), (0, 0)))
    cnt_base = jnp.arange(S) + 1
    outs = []
    for g, w in enumerate(POOL_WINDOWS):
        sl = slice(g * POOL_GROUP_DIM, (g + 1) * POOL_GROUP_DIM)
        cg = cs[..., sl]
        lag = jnp.pad(cg[:, :S + 1 - w], ((0, 0), (w - 1, 0), (0, 0)))
        cnt = jnp.minimum(cnt_base, w).astype(jnp.float32)[None, :, None]
        outs.append((cg[:, 1:] - lag) / cnt - uf[..., sl])
    p = jnp.stack(outs, axis=2).astype(u.dtype)
    y = jnp.einsum('bsgc,gcd->bsgd', p, pool_w).reshape(B, S, POOL_DIM)
    return y * pool_scale


def causal_block_attention(q_nope, q_rope, k_nope, k_rope, v):
    B, S, H, _ = q_nope.shape
    nb = S // Q_BLOCK
    scale = (QK_NOPE_DIM + QK_ROPE_DIM) ** -0.5
    k_idx = jnp.arange(S)

    def one_block(args):
        qn, qr, i = args
        s = (jnp.einsum('bqhd,bkhd->bhqk', qn, k_nope)
             + jnp.einsum('bqhr,bkr->bhqk', qr, k_rope)).astype(jnp.float32) * scale
        q_idx = i * Q_BLOCK + jnp.arange(Q_BLOCK)
        s = jnp.where(k_idx[None, :] <= q_idx[:, None], s, NEG_INF)
        p = jax.nn.softmax(s, axis=-1).astype(v.dtype)
        return jnp.einsum('bhqk,bkhd->bqhd', p, v)

    qn_b = q_nope.reshape(B, nb, Q_BLOCK, H, -1).transpose(1, 0, 2, 3, 4)
    qr_b = q_rope.reshape(B, nb, Q_BLOCK, H, -1).transpose(1, 0, 2, 3, 4)
    out = lax.map(one_block, (qn_b, qr_b, jnp.arange(nb)))
    return out.transpose(1, 0, 2, 3, 4).reshape(B, S, H, V_HEAD_DIM)


def mla_branch(q_down, kv_down, k_rope_in, cos, sin, q_norm_g, w_uq, kv_norm_g, w_uk, w_uv):
    B, S, _ = q_down.shape
    c_q = rms_norm(q_down, q_norm_g)
    q = (c_q @ w_uq).reshape(B, S, MLA_HEADS, QK_NOPE_DIM + QK_ROPE_DIM)
    q_nope = q[..., :QK_NOPE_DIM]
    q_rope = apply_rope(q[..., QK_NOPE_DIM:], cos[:, :, None, :], sin[:, :, None, :])
    c_kv = rms_norm(kv_down, kv_norm_g)
    k_nope = (c_kv @ w_uk).reshape(B, S, MLA_HEADS, QK_NOPE_DIM)
    v = (c_kv @ w_uv).reshape(B, S, MLA_HEADS, V_HEAD_DIM)
    k_rope = apply_rope(k_rope_in, cos, sin)
    return causal_block_attention(q_nope, q_rope, k_nope, k_rope, v).reshape(B, S, MLA_V_DIM)


def memory_cross_attention(xq, mem_n, w_mem_kv):
    B, S, _ = xq.shape
    kv = mem_n @ w_mem_kv
    k = kv[..., :XATTN_DIM].reshape(B, -1, XATTN_HEADS, XATTN_HEAD_DIM)
    v = kv[..., XATTN_DIM:].reshape(B, -1, XATTN_HEADS, XATTN_HEAD_DIM)
    q = xq.reshape(B, S, XATTN_HEADS, XATTN_HEAD_DIM)
    s = jnp.einsum('bshd,bmhd->bhsm', q, k).astype(jnp.float32) * (XATTN_HEAD_DIM ** -0.5)
    p = jax.nn.softmax(s, axis=-1).astype(v.dtype)
    return jnp.einsum('bhsm,bmhd->bshd', p, v).reshape(B, S, XATTN_DIM)


def hierarchical_moe(h, w_rg, b_rg, w_re, b_re, w_gate_e, w_up_e, w_down_e):
    B, S, D = h.shape
    T = B * S
    xt = h.reshape(T, D)
    g_logits = (xt @ w_rg).astype(jnp.float32) + b_rg.astype(jnp.float32)
    g_probs = jax.nn.softmax(g_logits, axis=-1)
    g_idx = jnp.argmax(g_logits, axis=-1)
    p_g = jnp.take_along_axis(g_probs, g_idx[:, None], axis=1)
    e_logits = ((xt @ w_re).astype(jnp.float32) + b_re.astype(jnp.float32)).reshape(T, N_GROUPS, EXPERTS_PER_GROUP)
    e_sel = jnp.take_along_axis(e_logits, g_idx[:, None, None], axis=1)[:, 0]
    p_e = jax.nn.softmax(e_sel, axis=-1)
    top_p, top_i = lax.top_k(p_e, TOP_K)
    weights = p_g * top_p / jnp.sum(top_p, axis=-1, keepdims=True)
    expert_idx = g_idx[:, None] * EXPERTS_PER_GROUP + top_i

    A = T * TOP_K
    e_flat = expert_idx.reshape(A).astype(jnp.int32)
    tok_flat = jnp.repeat(jnp.arange(T, dtype=jnp.int32), TOP_K)
    w_flat = weights.reshape(A)
    order = jnp.argsort(e_flat)
    e_sorted = e_flat[order]
    counts = jnp.bincount(e_flat, length=N_EXPERTS)
    padded = ((counts + MOE_BLOCK - 1) // MOE_BLOCK) * MOE_BLOCK
    pad_end = jnp.cumsum(padded)
    pad_start = pad_end - padded
    start = jnp.cumsum(counts) - counts
    dest = pad_start[e_sorted] + (jnp.arange(A) - start[e_sorted])
    R = ((A + MOE_BLOCK - 1) // MOE_BLOCK) * MOE_BLOCK + N_EXPERTS * MOE_BLOCK
    n_blk = R // MOE_BLOCK
    row_tok = jnp.full((R,), T, dtype=jnp.int32).at[dest].set(tok_flat[order])
    row_w = jnp.zeros((R,), dtype=jnp.float32).at[dest].set(w_flat[order])
    blk_e = jnp.minimum(jnp.searchsorted(pad_end, jnp.arange(n_blk) * MOE_BLOCK, side='right'), N_EXPERTS - 1)
    x_pad = jnp.concatenate([xt, jnp.zeros((1, D), xt.dtype)], axis=0)

    def run_block(args):
        toks, e = args
        xb = x_pad[toks]
        a = jax.nn.silu(xb @ w_gate_e[e]) * (xb @ w_up_e[e])
        return a @ w_down_e[e]

    yb = lax.map(run_block, (row_tok.reshape(n_blk, MOE_BLOCK), blk_e))
    y = yb.reshape(R, D) * row_w[:, None].astype(yb.dtype)
    out = jax.ops.segment_sum(y, row_tok, num_segments=T + 1)[:T]
    return out.reshape(B, S, D)


def setup_inputs(seed: int = 0) -> dict:
    key = jax.random.key(seed)
    ks = jax.random.split(key, 32)
    f32 = jnp.float32

    def dense(k, shape, fan_in):
        return jax.random.normal(k, shape, f32) * (fan_in ** -0.5)

    def gain(k, shape):
        return 1.0 + 0.05 * jax.random.normal(k, shape, f32)

    L = DEPTH
    return {
        "x": jax.random.normal(ks[0], (BATCH, SEQ, D_MODEL), f32),
        "mem": jax.random.normal(ks[1], (BATCH, MEM_LEN, D_MODEL), f32),
        "positions": (jnp.arange(SEQ, dtype=jnp.int32)[None, :]
                      + jax.random.randint(ks[2], (BATCH, 1), 0, 1024, dtype=jnp.int32)),
        "mix_norm_g": gain(ks[3], (L, D_MODEL)),
        "w_in": dense(ks[4], (L, D_MODEL, D_IN), D_MODEL),
        "gate_b": 0.02 * jax.random.normal(ks[5], (L, N_BRANCHES, D_MODEL), f32),
        "q_norm_g": gain(ks[6], (L, Q_LORA_RANK)),
        "w_uq": dense(ks[7], (L, Q_LORA_RANK, MLA_HEADS * (QK_NOPE_DIM + QK_ROPE_DIM)), Q_LORA_RANK),
        "kv_norm_g": gain(ks[8], (L, KV_LORA_RANK)),
        "w_uk": dense(ks[9], (L, KV_LORA_RANK, MLA_HEADS * QK_NOPE_DIM), KV_LORA_RANK),
        "w_uv": dense(ks[10], (L, KV_LORA_RANK, MLA_V_DIM), KV_LORA_RANK),
        "pool_w": dense(ks[11], (L, POOL_GROUPS, POOL_GROUP_DIM, POOL_GROUP_DIM), POOL_GROUP_DIM),
        "pool_scale": gain(ks[12], (L, POOL_DIM)),
        "mem_norm_g": gain(ks[13], (L, D_MODEL)),
        "w_mem_kv": dense(ks[14], (L, D_MODEL, 2 * XATTN_DIM), D_MODEL),
        "w_br_pool": dense(ks[15], (L, POOL_DIM, D_MODEL), POOL_DIM),
        "w_br_mla": dense(ks[16], (L, MLA_V_DIM, D_MODEL), MLA_V_DIM),
        "w_br_mem": dense(ks[17], (L, XATTN_DIM, D_MODEL), XATTN_DIM),
        "w_out": dense(ks[18], (L, D_MODEL, D_MODEL), D_MODEL),
        "ffn_norm_g": gain(ks[19], (L, D_MODEL)),
        "w_router_group": dense(ks[20], (L, D_MODEL, N_GROUPS), D_MODEL),
        "b_router_group": 0.01 * jax.random.normal(ks[21], (L, N_GROUPS), f32),
        "w_router_expert": dense(ks[22], (L, D_MODEL, N_EXPERTS), D_MODEL),
        "b_router_expert": 0.01 * jax.random.normal(ks[23], (L, N_EXPERTS), f32),
        "w_gate_e": dense(ks[24], (L, N_EXPERTS, D_MODEL, D_EXPERT), D_MODEL),
        "w_up_e": dense(ks[25], (L, N_EXPERTS, D_MODEL, D_EXPERT), D_MODEL),
        "w_down_e": dense(ks[26], (L, N_EXPERTS, D_EXPERT, D_MODEL), D_EXPERT),
        "final_norm_g": gain(ks[27], (D_MODEL,)),
    }


def reference(x, mem, positions, mix_norm_g, w_in, gate_b, q_norm_g, w_uq, kv_norm_g, w_uk, w_uv,
              pool_w, pool_scale, mem_norm_g, w_mem_kv, w_br_pool, w_br_mla, w_br_mem, w_out,
              ffn_norm_g, w_router_group, b_router_group, w_router_expert, b_router_expert,
              w_gate_e, w_up_e, w_down_e, final_norm_g):
    B, S, D = x.shape
    cos, sin = rope_tables(positions)
    split_points = list(np.cumsum(IN_SPLIT_SIZES)[:-1])
    for l in range(DEPTH):
        h = rms_norm(x, mix_norm_g[l])
        proj = h @ w_in[l]
        u_pool, q_down, kv_down, k_rope_in, xq, gate_logits = jnp.split(proj, split_points, axis=-1)
        y_pool = pool_mixer(u_pool, pool_w[l], pool_scale[l])
        y_mla = mla_branch(q_down, kv_down, k_rope_in, cos, sin,
                           q_norm_g[l], w_uq[l], kv_norm_g[l], w_uk[l], w_uv[l])
        y_mem = memory_cross_attention(xq, rms_norm(mem, mem_norm_g[l]), w_mem_kv[l])
        gates = jax.nn.sigmoid(gate_logits.reshape(B, S, N_BRANCHES, D) + gate_b[l])
        merged = (gates[:, :, 0] * (y_pool @ w_br_pool[l])
                  + gates[:, :, 1] * (y_mla @ w_br_mla[l])
                  + gates[:, :, 2] * (y_mem @ w_br_mem[l]))
        x = x + merged @ w_out[l]
        h2 = rms_norm(x, ffn_norm_g[l])
        x = x + hierarchical_moe(h2, w_router_group[l], b_router_group[l], w_router_expert[l],
                                 b_router_expert[l], w_gate_e[l], w_up_e[l], w_down_e[l])
    return rms_norm(x, final_norm_g)
```

```cpp
#include <hip/hip_runtime.h>
#include <cstdio>
#include <cstdint>

#define LAS __attribute__((address_space(3)))
typedef unsigned short bf16;
typedef float f32x4 __attribute__((ext_vector_type(4)));

constexpr int NB = 4, S = 4096, T = NB * S, D = 1024, DIN = 4800, MEMLEN = 256, MROWS = NB * MEMLEN;
constexpr int NE = 32, DE = 256;
constexpr float RMS_EPS = 1e-6f;
constexpr int NWAVES = 8, NTHREADS = 512;
constexpr float QSCALE_MLA = 0.07216878364870322f * 1.4426950408889634f;
constexpr float QSCALE_MEM = 0.08838834764831845f * 1.4426950408889634f;

constexpr size_t MiB = 1u << 20;
constexpr size_t WS_CTL = 0, CTL_ZERO_BYTES = 1 * MiB;
constexpr size_t WS_ROPEC = 1 * MiB, WS_ROPES = 3 * MiB, WS_RSQ = 5 * MiB, WS_RSKV = 5 * MiB + 65536, WS_AW = 5 * MiB + 131072;
constexpr size_t WS_MKV = 6 * MiB, WS_MEMN = 8 * MiB, WS_KR = 10 * MiB, WS_KRIN = 12 * MiB, WS_LIST = 16 * MiB;
constexpr size_t WS_A = 24 * MiB;
constexpr size_t WS_GATES = 56 * MiB;
constexpr size_t WS_HG = 56 * MiB, WS_HMID = 88 * MiB;
constexpr size_t WS_UPOOL = 152 * MiB;
constexpr size_t WS_XQ = 168 * MiB;
constexpr size_t WS_QDOWN = 184 * MiB;
constexpr size_t WS_KVDOWN = 196 * MiB;
constexpr size_t WS_P = 204 * MiB;
constexpr size_t WS_QR = 220 * MiB;
constexpr size_t WS_MERGED = 204 * MiB;
constexpr size_t WS_YSLOT = 152 * MiB;
constexpr size_t WS_END = 256 * MiB;
constexpr int CW_BAR = 4096, CW_CNT = 1024;

__device__ __forceinline__ float bf2f(bf16 v) { return __uint_as_float(((unsigned)v) << 16); }
__device__ __forceinline__ bf16 f2bf(float f) { unsigned u = __float_as_uint(f); u += 0x7fffu + ((u >> 16) & 1u); return (bf16)(u >> 16); }
__device__ __forceinline__ float wave_sum(float v) {
#pragma unroll
    for (int o = 1; o < 64; o <<= 1) v += __shfl_xor(v, o);
    return v;
}
__device__ __forceinline__ float wave_max(float v) {
#pragma unroll
    for (int o = 1; o < 64; o <<= 1) v = fmaxf(v, __shfl_xor(v, o));
    return v;
}

#define XB_TMO      128
#define XB_XCNT(j)  (256  + 64 * (j))
#define XB_XSUB(j)  (1280 + 64 * (j))
#define XB_XGEN(j)  (2304 + 64 * (j))
#define XB_TOP      3328
#define XB_TOPGEN   3392
#define XCD_BAR_WORDS 3456
#define XB_SPIN_CAP (1u << 18)

__device__ __forceinline__ unsigned xb_ld(unsigned* p)              { return __hip_atomic_load(p, __ATOMIC_RELAXED, __HIP_MEMORY_SCOPE_AGENT); }
__device__ __forceinline__ unsigned xb_add(unsigned* p, unsigned v) { return __hip_atomic_fetch_add(p, v, __ATOMIC_RELAXED, __HIP_MEMORY_SCOPE_AGENT); }
__device__ __forceinline__ unsigned xb_xcc_id() { return (unsigned)__builtin_amdgcn_s_getreg((3 << 11) | 20) & 0xFu; }
#define XB_SPIN(cond, bar) do { unsigned _sp = 0; while (cond) { __builtin_amdgcn_s_sleep(1); \
    if ((++_sp & 255u) == 0u) { if (xb_ld(&(bar)[XB_TMO])) break; if (_sp > XB_SPIN_CAP) { atomicAdd(&(bar)[XB_TMO], 1u); break; } } } } while (0)

struct XcdBarrier { unsigned* bar; unsigned x; volatile LAS unsigned* st; };

__device__ __forceinline__ XcdBarrier xcd_barrier_post(unsigned* bar, volatile LAS unsigned* st) {
    XcdBarrier b; b.bar = bar; b.x = xb_xcc_id(); b.st = st;
    if (threadIdx.x == 0) (void)xb_add(&bar[XB_XCNT(b.x)], 1u);
    return b;
}
__device__ __forceinline__ void xcd_barrier_complete(unsigned* bar, unsigned x, unsigned& nloc, unsigned& nx) {
    const unsigned G = gridDim.x * gridDim.y * gridDim.z;
    unsigned sum, cnt, mine, sp = 0u;
    for (;;) {
        sum = 0u; cnt = 0u; mine = 0u;
#pragma unroll
        for (unsigned j = 0; j < 16; ++j) { const unsigned c = xb_ld(&bar[XB_XCNT(j)]); sum += c; cnt += (c > 0u) ? 1u : 0u; mine = (j == x) ? c : mine; }
        if (sum == G) break;
        __builtin_amdgcn_s_sleep(1);
        if ((++sp & 255u) == 0u) { if (xb_ld(&bar[XB_TMO])) break; if (sp > XB_SPIN_CAP) { atomicAdd(&bar[XB_TMO], 1u); break; } }
    }
    nloc = mine > 0u ? mine : 1u; nx = cnt > 0u ? cnt : 1u;
}
__device__ __forceinline__ void xcd_barrier(const XcdBarrier& b) {
    asm volatile("s_waitcnt vmcnt(0)" ::: "memory");
    __syncthreads();
    if (threadIdx.x == 0) {
        unsigned* bar = b.bar;
        __builtin_amdgcn_s_waitcnt(0);
        unsigned nloc = b.st[0], nx = b.st[1];
        if (nloc == 0u) { xcd_barrier_complete(bar, b.x, nloc, nx); b.st[0] = nloc; b.st[1] = nx; }
        const unsigned old = xb_add(&bar[XB_XSUB(b.x)], 1u);
        const unsigned gen = old / nloc;
        if (old + 1u == (gen + 1u) * nloc) {
            __builtin_amdgcn_fence(__ATOMIC_RELEASE, "agent");
            asm volatile("s_waitcnt vmcnt(0)" ::: "memory");
            const unsigned og = xb_add(&bar[XB_TOP], 1u);
            const unsigned tg = og / nx;
            if (og + 1u == (tg + 1u) * nx) xb_add(&bar[XB_TOPGEN], 1u);
            else XB_SPIN(xb_ld(&bar[XB_TOPGEN]) == tg, bar);
            __builtin_amdgcn_fence(__ATOMIC_ACQUIRE, "agent");
            xb_add(&bar[XB_XGEN(b.x)], 1u);
            asm volatile("s_waitcnt vmcnt(0)" ::: "memory");
        } else {
            XB_SPIN(xb_ld(&bar[XB_XGEN(b.x)]) == gen, bar);
            __builtin_amdgcn_fence(__ATOMIC_ACQUIRE, "agent");
            asm volatile("s_waitcnt vmcnt(0)" ::: "memory");
        }
    }
    __syncthreads();
}

template <class FA, class FB, class FE>
__device__ __forceinline__ void ngemm(LAS float* sm, int M, int N, int K, int& tile_off, FA fa, FB fb, FE fe) {
    LAS float* As = sm;
    LAS float* Bs = sm + 16 * 65 + 15;
    Bs = sm + 1040;
    const int tid = threadIdx.x, ty = tid >> 4, tx = tid & 15, G = gridDim.x;
    const int tn = (N + 63) / 64, tm = (M + 63) / 64, tiles = tn * tm;
    int first = ((int)blockIdx.x - (tile_off % G) + G) % G;
    for (int t = first; t < tiles; t += G) {
        const int m0 = (t / tn) * 64, n0 = (t % tn) * 64;
        float acc[2][4];
#pragma unroll
        for (int i = 0; i < 2; ++i)
#pragma unroll
            for (int j = 0; j < 4; ++j) acc[i][j] = 0.f;
        for (int k0 = 0; k0 < K; k0 += 16) {
            __syncthreads();
#pragma unroll
            for (int j = 0; j < 2; ++j) {
                const int idx = tid + 512 * j;
                { const int m = idx >> 4, k = idx & 15; As[k * 65 + m] = (m0 + m < M) ? fa(m0 + m, k0 + k) : 0.f; }
                { const int k = idx >> 6, n = idx & 63; Bs[k * 64 + n] = (n0 + n < N) ? fb(k0 + k, n0 + n) : 0.f; }
            }
            __syncthreads();
#pragma unroll
            for (int k = 0; k < 16; ++k) {
                const float a0 = As[k * 65 + ty * 2], a1 = As[k * 65 + ty * 2 + 1];
                const f32x4 b = *(const LAS f32x4*)(Bs + k * 64 + tx * 4);
                acc[0][0] += a0 * b[0]; acc[0][1] += a0 * b[1]; acc[0][2] += a0 * b[2]; acc[0][3] += a0 * b[3];
                acc[1][0] += a1 * b[0]; acc[1][1] += a1 * b[1]; acc[1][2] += a1 * b[2]; acc[1][3] += a1 * b[3];
            }
        }
#pragma unroll
        for (int i = 0; i < 2; ++i)
#pragma unroll
            for (int j = 0; j < 4; ++j) { const int m = m0 + ty * 2 + i, n = n0 + tx * 4 + j; if (m < M && n < N) fe(m, n, acc[i][j]); }
    }
    tile_off += tiles;
}

struct Args { const float* in[28]; float* out; unsigned char* ws; int ph_lo, ph_hi; };

constexpr int LDS_BYTES = 147456;
constexpr int N_PHASES = 13;

__global__ void __launch_bounds__(NTHREADS, 2) fwd(Args args) {
    extern __shared__ __attribute__((aligned(16))) unsigned char lds_raw[];
    LAS unsigned char* lds = (LAS unsigned char*)lds_raw;
    LAS float* sm = (LAS float*)lds;
    LAS float* wsm = (LAS float*)(lds + 16384);
    volatile LAS unsigned* MISC = (volatile LAS unsigned*)(lds + 32768);
    const int tid = threadIdx.x, lane = tid & 63, wave = tid >> 6, G = gridDim.x;
    const int gw = blockIdx.x * NWAVES + wave, NGW = G * NWAVES;
    unsigned char* ws = args.ws;
    unsigned* ctl = (unsigned*)(ws + WS_CTL);
    if (tid < 32) MISC[tid] = 0u;
    __syncthreads();
    XcdBarrier bar = xcd_barrier_post(ctl + CW_BAR, MISC + 8);
    const int lo = args.ph_lo, hi = args.ph_hi;
#define IN(k) (lo <= (k) && (k) < hi)
#ifndef PH_MASK
#define PH_MASK 0xffff
#endif
#define PHEN(k) (((PH_MASK) >> (k)) & 1)
#define SEAM(k) do { if (IN(k) && IN((k) + 1)) xcd_barrier(bar); } while (0)

#define xin (args.in[0])
#define memin (args.in[1])
#define mix_g (args.in[3])
#define w_in (args.in[4])
#define gate_b (args.in[5])
#define q_g (args.in[6])
#define w_uq (args.in[7])
#define kv_g (args.in[8])
#define w_uk (args.in[9])
#define w_uv (args.in[10])
#define pool_w (args.in[11])
#define pool_scale (args.in[12])
#define mem_g (args.in[13])
#define w_mem_kv (args.in[14])
#define w_br_pool (args.in[15])
#define w_br_mla (args.in[16])
#define w_br_mem (args.in[17])
#define w_out (args.in[18])
#define ffn_g (args.in[19])
#define w_rg (args.in[20])
#define b_rg (args.in[21])
#define w_re (args.in[22])
#define b_re (args.in[23])
#define w_gate_e (args.in[24])
#define w_up_e (args.in[25])
#define w_down_e (args.in[26])
#define final_g (args.in[27])
#define positions ((const int*)args.in[2])
#define ropeC ((float*)(ws + WS_ROPEC))
#define ropeS ((float*)(ws + WS_ROPES))
#define rsq ((float*)(ws + WS_RSQ))
#define rskv ((float*)(ws + WS_RSKV))
#define aw ((float*)(ws + WS_AW))
#define mkv ((bf16*)(ws + WS_MKV))
#define memn ((bf16*)(ws + WS_MEMN))
#define kr ((bf16*)(ws + WS_KR))
#define krin ((float*)(ws + WS_KRIN))
#define list ((int*)(ws + WS_LIST))
#define hb ((bf16*)(ws + WS_A))
#define qn ((bf16*)(ws + WS_A))
#define ymla ((bf16*)(ws + WS_A))
#define h2 ((bf16*)(ws + WS_A))
#define gates ((bf16*)(ws + WS_GATES))
#define hg ((float*)(ws + WS_HG))
#define hmid ((bf16*)(ws + WS_HMID))
#define upool ((bf16*)(ws + WS_UPOOL))
#define ypool ((bf16*)(ws + WS_UPOOL))
#define xq ((bf16*)(ws + WS_XQ))
#define ymem ((bf16*)(ws + WS_XQ))
#define qdown ((bf16*)(ws + WS_QDOWN))
#define kvdown ((bf16*)(ws + WS_KVDOWN))
#define pp ((bf16*)(ws + WS_P))
#define qr ((bf16*)(ws + WS_QR))
#define merged ((bf16*)(ws + WS_MERGED))
#define yslot ((bf16*)(ws + WS_YSLOT))
#define kn ((bf16*)args.out)
#define vv ((bf16*)args.out + (size_t)T * D)
#define m32 (args.out)
#define x1 (args.out)
    unsigned* cnt = ctl + CW_CNT;
    int toff = 0;

    if (PHEN(0) && IN(0)) {
        for (int r = gw; r < T + MROWS; r += NGW) {
            const bool is_x = r < T; const float* src = is_x ? xin + (size_t)r * D : memin + (size_t)(r - T) * D;
            const float* g = is_x ? mix_g : mem_g; bf16* dst = is_x ? hb + (size_t)r * D : memn + (size_t)(r - T) * D;
            float v[16]; float s = 0.f;
#pragma unroll
            for (int j = 0; j < 4; ++j) { const f32x4 q = *(const f32x4*)(src + j * 256 + lane * 4); v[4*j] = q[0]; v[4*j+1] = q[1]; v[4*j+2] = q[2]; v[4*j+3] = q[3]; s += q[0]*q[0] + q[1]*q[1] + q[2]*q[2] + q[3]*q[3]; }
            const float rs = 1.0f / sqrtf(wave_sum(s) * (1.f / D) + RMS_EPS);
#pragma unroll
            for (int j = 0; j < 4; ++j)
#pragma unroll
                for (int i = 0; i < 4; ++i) { const int c = j * 256 + lane * 4 + i; dst[c] = f2bf(v[4*j+i] * rs * g[c]); }
        }
        for (int i = blockIdx.x * NTHREADS + tid; i < T * 32; i += G * NTHREADS) {
            const int t = i >> 5, f = i & 31;
            const double inv = pow(10000.0, -(double)(2 * f) / 64.0);
            const float invf = (float)inv;
            const float ang = (float)positions[t] * invf;
            ropeC[i] = (float)cos((double)ang); ropeS[i] = (float)sin((double)ang);
        }
    }
    SEAM(0);
    if (PHEN(1) && IN(1)) {
        ngemm(sm, T, DIN, D, toff,
              [&](int m, int k) { return bf2f(hb[(size_t)m * D + k]); },
              [&](int k, int n) { return w_in[(size_t)k * DIN + n]; },
              [&](int m, int n, float a) {
                  if (n < 512) upool[(size_t)m * 512 + n] = f2bf(a);
                  else if (n < 896) qdown[(size_t)m * 384 + (n - 512)] = f2bf(a);
                  else if (n < 1152) kvdown[(size_t)m * 256 + (n - 896)] = f2bf(a);
                  else if (n < 1216) krin[(size_t)m * 64 + (n - 1152)] = a;
                  else if (n < 1728) xq[(size_t)m * 512 + (n - 1216)] = f2bf(a * QSCALE_MEM);
                  else { const int j = n - 1728; gates[(size_t)m * 3072 + j] = f2bf(1.f / (1.f + __expf(-(a + gate_b[j])))); }
              });
        ngemm(sm, MROWS, 1024, D, toff,
              [&](int m, int k) { return bf2f(memn[(size_t)m * D + k]); },
              [&](int k, int n) { return w_mem_kv[(size_t)k * 1024 + n]; },
              [&](int m, int n, float a) { mkv[(size_t)m * 1024 + n] = f2bf(a); });
    }
    SEAM(1);
    if (PHEN(2) && IN(2)) {
        for (int t = gw; t < T; t += NGW) {
            float s = 0.f;
#pragma unroll
            for (int j = 0; j < 6; ++j) { const float v = bf2f(qdown[(size_t)t * 384 + j * 64 + lane]); s += v * v; }
            s = wave_sum(s);
            float s2 = 0.f;
#pragma unroll
            for (int j = 0; j < 4; ++j) { const float v = bf2f(kvdown[(size_t)t * 256 + j * 64 + lane]); s2 += v * v; }
            s2 = wave_sum(s2);
            if (lane == 0) { rsq[t] = 1.0f / sqrtf(s * (1.f / 384.f) + RMS_EPS); rskv[t] = 1.0f / sqrtf(s2 * (1.f / 256.f) + RMS_EPS); }
            if (lane < 32) {
                const float a = krin[(size_t)t * 64 + lane], b = krin[(size_t)t * 64 + 32 + lane], c = ropeC[t * 32 + lane], sn = ropeS[t * 32 + lane];
                kr[(size_t)t * 64 + lane] = f2bf(a * c - b * sn); kr[(size_t)t * 64 + 32 + lane] = f2bf(b * c + a * sn);
            }
            const int sidx = t & (S - 1);
#pragma unroll
            for (int j = 0; j < 8; ++j) {
                const int c = j * 64 + lane, g = c >> 7, w = 2 << g;
                const int n = (sidx + 1 < w) ? sidx + 1 : w;
                float sum = 0.f;
                for (int i = 0; i < n; ++i) sum += bf2f(upool[(size_t)(t - i) * 512 + c]);
                pp[(size_t)t * 512 + c] = f2bf(sum / (float)n - bf2f(upool[(size_t)t * 512 + c]));
            }
        }
    }
    SEAM(2);
    if (PHEN(3) && IN(3)) {
        ngemm(sm, T, 1536, 384, toff,
              [&](int m, int k) { return bf2f(qdown[(size_t)m * 384 + k]) * q_g[k]; },
              [&](int k, int n) { return w_uq[(size_t)k * 1536 + n]; },
              [&](int m, int n, float a) { const int hh = n / 192, j = n - hh * 192; const float v = a * rsq[m] * QSCALE_MLA;
                  if (j < 128) qn[(size_t)m * 1024 + hh * 128 + j] = f2bf(v); else qr[(size_t)m * 512 + hh * 64 + (j - 128)] = f2bf(v); });
        ngemm(sm, T, 1024, 256, toff,
              [&](int m, int k) { return bf2f(kvdown[(size_t)m * 256 + k]) * kv_g[k]; },
              [&](int k, int n) { return w_uk[(size_t)k * 1024 + n]; },
              [&](int m, int n, float a) { kn[(size_t)m * 1024 + n] = f2bf(a * rskv[m]); });
        ngemm(sm, T, 1024, 256, toff,
              [&](int m, int k) { return bf2f(kvdown[(size_t)m * 256 + k]) * kv_g[k]; },
              [&](int k, int n) { return w_uv[(size_t)k * 1024 + n]; },
              [&](int m, int n, float a) { vv[(size_t)m * 1024 + n] = f2bf(a * rskv[m]); });
    }
    SEAM(3);
    if (PHEN(4) && IN(4)) {
        for (int i = blockIdx.x * NTHREADS + tid; i < T * 8 * 32; i += G * NTHREADS) {
            const int t = i >> 8, hh = (i >> 5) & 7, f = i & 31;
            bf16* p = qr + (size_t)t * 512 + hh * 64;
            const float a = bf2f(p[f]), b = bf2f(p[32 + f]), c = ropeC[t * 32 + f], sn = ropeS[t * 32 + f];
            p[f] = f2bf(a * c - b * sn); p[32 + f] = f2bf(b * c + a * sn);
        }
    }
    SEAM(4);
    if (PHEN(5) && IN(5)) {
        LAS float* qs = wsm + wave * 256;
        for (int task = gw; task < T * 8; task += NGW) {
            const int t = task >> 3, hh = task & 7, b = t >> 12, sidx = t & (S - 1);
            qs[lane] = bf2f(qn[(size_t)t * 1024 + hh * 128 + lane]); qs[64 + lane] = bf2f(qn[(size_t)t * 1024 + hh * 128 + 64 + lane]);
            qs[128 + lane] = bf2f(qr[(size_t)t * 512 + hh * 64 + lane]);
            asm volatile("s_waitcnt lgkmcnt(0)" ::: "memory");
            float m_run = -1e30f, l_run = 0.f, o0 = 0.f, o1 = 0.f;
            for (int j0 = 0; j0 <= sidx; j0 += 64) {
                asm volatile("" ::: "memory");
                const int key = j0 + lane; const bool valid = key <= sidx; const size_t kt = (size_t)(b * S + (valid ? key : sidx));
                float sc = 0.f;
                const bf16* kp = kn + kt * 1024 + hh * 128;
#pragma unroll 2
                for (int k = 0; k < 128; k += 8) { const uint4 w = *(const uint4*)(kp + k); const unsigned ww[4] = {w.x, w.y, w.z, w.w};
#pragma unroll
                    for (int i = 0; i < 4; ++i) { sc += qs[k + 2*i] * __uint_as_float(ww[i] << 16) + qs[k + 2*i + 1] * __uint_as_float(ww[i] & 0xffff0000u); } }
                const bf16* rp = kr + kt * 64;
#pragma unroll 2
                for (int k = 0; k < 64; k += 8) { const uint4 w = *(const uint4*)(rp + k); const unsigned ww[4] = {w.x, w.y, w.z, w.w};
#pragma unroll
                    for (int i = 0; i < 4; ++i) { sc += qs[128 + k + 2*i] * __uint_as_float(ww[i] << 16) + qs[128 + k + 2*i + 1] * __uint_as_float(ww[i] & 0xffff0000u); } }
                if (!valid) sc = -1e30f;
                const float mn = fmaxf(m_run, wave_max(sc));
                const float alpha = exp2f(m_run - mn);
                const float p = valid ? exp2f(sc - mn) : 0.f;
                l_run = l_run * alpha + wave_sum(p); o0 *= alpha; o1 *= alpha; m_run = mn;
                const int nk = (sidx - j0 + 1 < 64) ? sidx - j0 + 1 : 64;
                for (int j = 0; j < nk; ++j) {
                    const float pj = __shfl(p, j);
                    const unsigned w = *(const unsigned*)(vv + (size_t)(b * S + j0 + j) * 1024 + hh * 128 + lane * 2);
                    o0 += pj * __uint_as_float(w << 16); o1 += pj * __uint_as_float(w & 0xffff0000u);
                }
            }
            const float il = 1.f / l_run;
            *(unsigned*)(ymla + (size_t)t * 1024 + hh * 128 + lane * 2) = (unsigned)f2bf(o0 * il) | ((unsigned)f2bf(o1 * il) << 16);
        }
        for (int task = gw; task < T * 4; task += NGW) {
            const int t = task >> 2, hh = task & 3, b = t >> 12;
            qs[lane] = bf2f(xq[(size_t)t * 512 + hh * 128 + lane]); qs[64 + lane] = bf2f(xq[(size_t)t * 512 + hh * 128 + 64 + lane]);
            asm volatile("s_waitcnt lgkmcnt(0)" ::: "memory");
            float m_run = -1e30f, l_run = 0.f, o0 = 0.f, o1 = 0.f;
            for (int j0 = 0; j0 < MEMLEN; j0 += 64) {
                asm volatile("" ::: "memory");
                const size_t kt = (size_t)(b * MEMLEN + j0 + lane);
                float sc = 0.f;
                const bf16* kp = mkv + kt * 1024 + hh * 128;
#pragma unroll 2
                for (int k = 0; k < 128; k += 8) { const uint4 w = *(const uint4*)(kp + k); const unsigned ww[4] = {w.x, w.y, w.z, w.w};
#pragma unroll
                    for (int i = 0; i < 4; ++i) { sc += qs[k + 2*i] * __uint_as_float(ww[i] << 16) + qs[k + 2*i + 1] * __uint_as_float(ww[i] & 0xffff0000u); } }
                const float mn = fmaxf(m_run, wave_max(sc));
                const float alpha = exp2f(m_run - mn);
                const float p = exp2f(sc - mn);
                l_run = l_run * alpha + wave_sum(p); o0 *= alpha; o1 *= alpha; m_run = mn;
                for (int j = 0; j < 64; ++j) {
                    const float pj = __shfl(p, j);
                    const unsigned w = *(const unsigned*)(mkv + (size_t)(b * MEMLEN + j0 + j) * 1024 + 512 + hh * 128 + lane * 2);
                    o0 += pj * __uint_as_float(w << 16); o1 += pj * __uint_as_float(w & 0xffff0000u);
                }
            }
            const float il = 1.f / l_run;
            *(unsigned*)(ymem + (size_t)t * 512 + hh * 128 + lane * 2) = (unsigned)f2bf(o0 * il) | ((unsigned)f2bf(o1 * il) << 16);
        }
    }
    SEAM(5);
    if (PHEN(6) && IN(6)) {
        for (int g = 0; g < 4; ++g)
            ngemm(sm, T, 128, 128, toff,
                  [&](int m, int k) { return bf2f(pp[(size_t)m * 512 + g * 128 + k]); },
                  [&](int k, int n) { return pool_w[(size_t)g * 16384 + k * 128 + n]; },
                  [&](int m, int n, float a) { ypool[(size_t)m * 512 + g * 128 + n] = f2bf(a * pool_scale[g * 128 + n]); });
    }
    SEAM(6);
    if (PHEN(7) && IN(7)) {
        int to = toff;
        ngemm(sm, T, D, 512, to,
              [&](int m, int k) { return bf2f(ypool[(size_t)m * 512 + k]); },
              [&](int k, int n) { return w_br_pool[(size_t)k * D + n]; },
              [&](int m, int n, float a) { m32[(size_t)m * D + n] = a * bf2f(gates[(size_t)m * 3072 + n]); });
        to = toff;
        ngemm(sm, T, D, 1024, to,
              [&](int m, int k) { return bf2f(ymla[(size_t)m * 1024 + k]); },
              [&](int k, int n) { return w_br_mla[(size_t)k * D + n]; },
              [&](int m, int n, float a) { m32[(size_t)m * D + n] += a * bf2f(gates[(size_t)m * 3072 + 1024 + n]); });
        to = toff;
        ngemm(sm, T, D, 512, to,
              [&](int m, int k) { return bf2f(ymem[(size_t)m * 512 + k]); },
              [&](int k, int n) { return w_br_mem[(size_t)k * D + n]; },
              [&](int m, int n, float a) { merged[(size_t)m * D + n] = f2bf(m32[(size_t)m * D + n] + a * bf2f(gates[(size_t)m * 3072 + 2048 + n])); });
        toff = to;
    }
    SEAM(7);
    if (PHEN(8) && IN(8)) {
        ngemm(sm, T, D, D, toff,
              [&](int m, int k) { return bf2f(merged[(size_t)m * D + k]); },
              [&](int k, int n) { return w_out[(size_t)k * D + n]; },
              [&](int m, int n, float a) { x1[(size_t)m * D + n] = xin[(size_t)m * D + n] + a; });
    }
    SEAM(8);
    if (PHEN(9) && IN(9)) {
        for (int t = gw; t < T; t += NGW) {
            float s = 0.f;
#pragma unroll
            for (int j = 0; j < 4; ++j) { const f32x4 q = *(const f32x4*)(x1 + (size_t)t * D + j * 256 + lane * 4); s += q[0]*q[0] + q[1]*q[1] + q[2]*q[2] + q[3]*q[3]; }
            const float rs = 1.0f / sqrtf(wave_sum(s) * (1.f / D) + RMS_EPS);
            float lg[36];
#pragma unroll
            for (int c = 0; c < 36; ++c) lg[c] = 0.f;
#pragma unroll 1
            for (int j = 0; j < 4; ++j) {
                const f32x4 q = *(const f32x4*)(x1 + (size_t)t * D + j * 256 + lane * 4);
                const f32x4 gq = *(const f32x4*)(ffn_g + j * 256 + lane * 4);
#pragma unroll
                for (int i = 0; i < 4; ++i) { const int k = j * 256 + lane * 4 + i; const float hv = q[i] * rs * gq[i];
                    h2[(size_t)t * D + k] = f2bf(hv);
                    const f32x4 wg = *(const f32x4*)(w_rg + (size_t)k * 4);
                    lg[0] += hv * wg[0]; lg[1] += hv * wg[1]; lg[2] += hv * wg[2]; lg[3] += hv * wg[3];
#pragma unroll
                    for (int c4 = 0; c4 < 8; ++c4) { const f32x4 we = *(const f32x4*)(w_re + (size_t)k * 32 + c4 * 4);
                        lg[4 + c4*4] += hv * we[0]; lg[5 + c4*4] += hv * we[1]; lg[6 + c4*4] += hv * we[2]; lg[7 + c4*4] += hv * we[3]; } }
            }
#pragma unroll
            for (int c = 0; c < 36; ++c) lg[c] = wave_sum(lg[c]);
            int gi = 0; float gmax = lg[0] + b_rg[0];
#pragma unroll
            for (int c = 1; c < 4; ++c) { const float l = lg[c] + b_rg[c]; if (l > gmax) { gmax = l; gi = c; } }
            float gden = 0.f;
#pragma unroll
            for (int c = 0; c < 4; ++c) gden += __expf(lg[c] + b_rg[c] - gmax);
            const float p_g = 1.f / gden;
            float el[8];
#pragma unroll
            for (int c = 0; c < 8; ++c) { float val = 0.f;
#pragma unroll
                for (int g2 = 0; g2 < 4; ++g2) val = (gi == g2) ? lg[4 + g2 * 8 + c] + b_re[g2 * 8 + c] : val;
                el[c] = val; }
            int i1 = 0; float l1 = el[0];
#pragma unroll
            for (int c = 1; c < 8; ++c) if (el[c] > l1) { l1 = el[c]; i1 = c; }
            int i2 = -1; float l2 = -3.0e38f;
#pragma unroll
            for (int c = 0; c < 8; ++c) if (c != i1 && el[c] > l2) { l2 = el[c]; i2 = c; }
            const float r = __expf(l2 - l1);
            const float w1 = p_g / (1.f + r), w2 = p_g * r / (1.f + r);
            if (lane == 0) {
                const int e1 = gi * 8 + i1, e2 = gi * 8 + i2;
                const unsigned p1 = atomicAdd(&cnt[e1], 1u); list[e1 * T + p1] = t * 2;
                const unsigned p2 = atomicAdd(&cnt[e2], 1u); list[e2 * T + p2] = t * 2 + 1;
                aw[t * 2] = w1; aw[t * 2 + 1] = w2;
            }
        }
    }
    SEAM(9);
    if (PHEN(10) && IN(10)) {
        int base = 0;
        for (int e = 0; e < NE; ++e) {
            const int ne = (int)cnt[e]; const int* le = list + e * T;
            const float* wg = w_gate_e + (size_t)e * D * DE; const float* wu = w_up_e + (size_t)e * D * DE;
            int to = toff;
            ngemm(sm, ne, DE, D, to,
                  [&](int m, int k) { return bf2f(h2[(size_t)(le[m] >> 1) * D + k]); },
                  [&](int k, int n) { return wg[(size_t)k * DE + n]; },
                  [&](int m, int n, float a) { hg[(size_t)(base + m) * DE + n] = a; });
            to = toff;
            ngemm(sm, ne, DE, D, to,
                  [&](int m, int k) { return bf2f(h2[(size_t)(le[m] >> 1) * D + k]); },
                  [&](int k, int n) { return wu[(size_t)k * DE + n]; },
                  [&](int m, int n, float a) { const float gg = hg[(size_t)(base + m) * DE + n]; hmid[(size_t)(base + m) * DE + n] = f2bf(gg / (1.f + __expf(-gg)) * a); });
            toff = to; base += ne;
        }
    }
    SEAM(10);
    if (PHEN(11) && IN(11)) {
        int base = 0;
        for (int e = 0; e < NE; ++e) {
            const int ne = (int)cnt[e]; const int* le = list + e * T;
            const float* wd = w_down_e + (size_t)e * DE * D;
            ngemm(sm, ne, D, DE, toff,
                  [&](int m, int k) { return bf2f(hmid[(size_t)(base + m) * DE + k]); },
                  [&](int k, int n) { return wd[(size_t)k * D + n]; },
                  [&](int m, int n, float a) { const int as = le[m]; yslot[(size_t)as * D + n] = f2bf(aw[as] * a); });
            base += ne;
        }
    }
    SEAM(11);
    if (PHEN(12) && IN(12)) {
        for (int t = gw; t < T; t += NGW) {
            float v[16]; float s = 0.f;
#pragma unroll
            for (int j = 0; j < 4; ++j) { const int c = j * 256 + lane * 4; const f32x4 q = *(const f32x4*)(x1 + (size_t)t * D + c);
                const uint2 y0 = *(const uint2*)(yslot + (size_t)(2 * t) * D + c), y1 = *(const uint2*)(yslot + (size_t)(2 * t + 1) * D + c);
                v[4*j]   = q[0] + __uint_as_float(y0.x << 16) + __uint_as_float(y1.x << 16);
                v[4*j+1] = q[1] + __uint_as_float(y0.x & 0xffff0000u) + __uint_as_float(y1.x & 0xffff0000u);
                v[4*j+2] = q[2] + __uint_as_float(y0.y << 16) + __uint_as_float(y1.y << 16);
                v[4*j+3] = q[3] + __uint_as_float(y0.y & 0xffff0000u) + __uint_as_float(y1.y & 0xffff0000u);
                s += v[4*j]*v[4*j] + v[4*j+1]*v[4*j+1] + v[4*j+2]*v[4*j+2] + v[4*j+3]*v[4*j+3]; }
            const float rs = 1.0f / sqrtf(wave_sum(s) * (1.f / D) + RMS_EPS);
#pragma unroll
            for (int j = 0; j < 4; ++j) { const int c = j * 256 + lane * 4; const f32x4 g = *(const f32x4*)(final_g + c);
                f32x4 o; o[0] = v[4*j] * rs * g[0]; o[1] = v[4*j+1] * rs * g[1]; o[2] = v[4*j+2] * rs * g[2]; o[3] = v[4*j+3] * rs * g[3];
                *(f32x4*)(args.out + (size_t)t * D + c) = o; }
        }
    }
#undef IN
#undef SEAM
}

extern "C" void kernel_launch(void* const* d_in, const int* in_sizes, int n_in, void* d_out, int out_size, void* d_ws, size_t ws_size, hipStream_t stream) {
    static int grid = 0;
    if (grid == 0) {
        if (n_in != 28 || out_size != T * D || ws_size < WS_END) { fprintf(stderr, "kernel_launch: unexpected shapes n_in %d out %d ws %zu\n", n_in, out_size, ws_size); grid = -1; return; }
        int dev = 0, cus = 0, per_cu = 0;
        if (hipGetDevice(&dev) != hipSuccess || hipDeviceGetAttribute(&cus, hipDeviceAttributeMultiprocessorCount, dev) != hipSuccess) { grid = -1; return; }
        if (hipFuncSetAttribute((const void*)fwd, hipFuncAttributeMaxDynamicSharedMemorySize, LDS_BYTES) != hipSuccess) { fprintf(stderr, "hipFuncSetAttribute failed\n"); grid = -1; return; }
        if (hipOccupancyMaxActiveBlocksPerMultiprocessor(&per_cu, (const void*)fwd, NTHREADS, LDS_BYTES) != hipSuccess || per_cu < 1) fprintf(stderr, "occupancy query: %d\n", per_cu);
        (void)hipGetLastError();
        grid = cus;
    }
    if (grid < 0) return;
    (void)hipMemsetAsync((char*)d_ws + WS_CTL, 0, CTL_ZERO_BYTES, stream);
    Args a{};
    for (int i = 0; i < 28; ++i) a.in[i] = (const float*)d_in[i];
    a.out = (float*)d_out; a.ws = (unsigned char*)d_ws; a.ph_lo = 0; a.ph_hi = N_PHASES;
    hipLaunchKernelGGL(fwd, dim3(grid), dim3(NTHREADS), LDS_BYTES, stream, a);
}
```

```cpp
#include <hip/hip_runtime.h>
#include <cstdio>
#include <cstdint>

#define LAS __attribute__((address_space(3)))
typedef unsigned short bf16;
typedef float f32x4 __attribute__((ext_vector_type(4)));

constexpr int NB = 4, S = 4096, T = NB * S, D = 1024, DIN = 4800, MEMLEN = 256, MROWS = NB * MEMLEN;
constexpr int NE = 32, DE = 256;
constexpr float RMS_EPS = 1e-6f;
constexpr int NWAVES = 8, NTHREADS = 512;
constexpr float QSCALE_MLA = 0.07216878364870322f * 1.4426950408889634f;
constexpr float QSCALE_MEM = 0.08838834764831845f * 1.4426950408889634f;

constexpr size_t MiB = 1u << 20;
constexpr size_t WS_CTL = 0, CTL_ZERO_BYTES = 1 * MiB;
constexpr size_t KiB = 1u << 10;
constexpr size_t WS_ROPEC = 1 * MiB, WS_ROPES = 3 * MiB, WS_RSQ = 5 * MiB, WS_RSKV = 5 * MiB + 64 * KiB, WS_AW = 6 * MiB + 768 * KiB;
constexpr size_t WS_MKV = 7 * MiB, WS_MEMN = 9 * MiB, WS_KR = 11 * MiB, WS_LIST = 13 * MiB, WS_WBRMEM = 15 * MiB;
constexpr size_t WS_WIN = 224 * MiB;
constexpr size_t WS_WUQ = 240 * MiB, WS_WUKV = WS_WUQ + 1152 * KiB, WS_WOUT = WS_WUKV + 1 * MiB, WS_WBRMLA = WS_WOUT + 2 * MiB,
                 WS_WMEMKV = WS_WBRMLA + 2 * MiB, WS_WBRPOOL = WS_WMEMKV + 2 * MiB;
static_assert(WS_WBRPOOL + 1 * MiB <= 256 * MiB, "weights fit");
constexpr int NPAD_IN = 4864;
constexpr size_t WS_A = 24 * MiB;
constexpr size_t WS_GATES = 56 * MiB;
constexpr size_t WS_HG = 56 * MiB, WS_HMID = 88 * MiB;
constexpr size_t WS_PXQ = 152 * MiB;
constexpr size_t WS_QKVD = 184 * MiB;
constexpr size_t WS_P = 208 * MiB;
constexpr size_t WS_QR = 224 * MiB;
constexpr size_t WS_MERGED = 184 * MiB;
constexpr size_t WS_YSLOT = 152 * MiB;
constexpr size_t WS_END = 256 * MiB;
constexpr int CW_BAR = 4096, CW_CNT = 1024;

__device__ __forceinline__ float bf2f(bf16 v) { return __uint_as_float(((unsigned)v) << 16); }
__device__ __forceinline__ bf16 f2bf(float f) { unsigned u = __float_as_uint(f); u += 0x7fffu + ((u >> 16) & 1u); return (bf16)(u >> 16); }
__device__ __forceinline__ float wave_sum(float v) {
#pragma unroll
    for (int o = 1; o < 64; o <<= 1) v += __shfl_xor(v, o);
    return v;
}
__device__ __forceinline__ float wave_max(float v) {
#pragma unroll
    for (int o = 1; o < 64; o <<= 1) v = fmaxf(v, __shfl_xor(v, o));
    return v;
}

#define XB_TMO      128
#define XB_XCNT(j)  (256  + 64 * (j))
#define XB_XSUB(j)  (1280 + 64 * (j))
#define XB_XGEN(j)  (2304 + 64 * (j))
#define XB_TOP      3328
#define XB_TOPGEN   3392
#define XCD_BAR_WORDS 3456
#define XB_SPIN_CAP (1u << 18)

__device__ __forceinline__ unsigned xb_ld(unsigned* p)              { return __hip_atomic_load(p, __ATOMIC_RELAXED, __HIP_MEMORY_SCOPE_AGENT); }
__device__ __forceinline__ unsigned xb_add(unsigned* p, unsigned v) { return __hip_atomic_fetch_add(p, v, __ATOMIC_RELAXED, __HIP_MEMORY_SCOPE_AGENT); }
__device__ __forceinline__ unsigned xb_xcc_id() { return (unsigned)__builtin_amdgcn_s_getreg((3 << 11) | 20) & 0xFu; }
#define XB_SPIN(cond, bar) do { unsigned _sp = 0; while (cond) { __builtin_amdgcn_s_sleep(1); \
    if ((++_sp & 255u) == 0u) { if (xb_ld(&(bar)[XB_TMO])) break; if (_sp > XB_SPIN_CAP) { atomicAdd(&(bar)[XB_TMO], 1u); break; } } } } while (0)

struct XcdBarrier { unsigned* bar; unsigned x; volatile LAS unsigned* st; };

__device__ __forceinline__ XcdBarrier xcd_barrier_post(unsigned* bar, volatile LAS unsigned* st) {
    XcdBarrier b; b.bar = bar; b.x = xb_xcc_id(); b.st = st;
    if (threadIdx.x == 0) (void)xb_add(&bar[XB_XCNT(b.x)], 1u);
    return b;
}
__device__ __forceinline__ void xcd_barrier_complete(unsigned* bar, unsigned x, unsigned& nloc, unsigned& nx) {
    const unsigned G = gridDim.x * gridDim.y * gridDim.z;
    unsigned sum, cnt, mine, sp = 0u;
    for (;;) {
        sum = 0u; cnt = 0u; mine = 0u;
#pragma unroll
        for (unsigned j = 0; j < 16; ++j) { const unsigned c = xb_ld(&bar[XB_XCNT(j)]); sum += c; cnt += (c > 0u) ? 1u : 0u; mine = (j == x) ? c : mine; }
        if (sum == G) break;
        __builtin_amdgcn_s_sleep(1);
        if ((++sp & 255u) == 0u) { if (xb_ld(&bar[XB_TMO])) break; if (sp > XB_SPIN_CAP) { atomicAdd(&bar[XB_TMO], 1u); break; } }
    }
    nloc = mine > 0u ? mine : 1u; nx = cnt > 0u ? cnt : 1u;
}
__device__ __forceinline__ void xcd_barrier(const XcdBarrier& b) {
    asm volatile("s_waitcnt vmcnt(0)" ::: "memory");
    __syncthreads();
    if (threadIdx.x == 0) {
        unsigned* bar = b.bar;
        __builtin_amdgcn_s_waitcnt(0);
        unsigned nloc = b.st[0], nx = b.st[1];
        if (nloc == 0u) { xcd_barrier_complete(bar, b.x, nloc, nx); b.st[0] = nloc; b.st[1] = nx; }
        const unsigned old = xb_add(&bar[XB_XSUB(b.x)], 1u);
        const unsigned gen = old / nloc;
        if (old + 1u == (gen + 1u) * nloc) {
            __builtin_amdgcn_fence(__ATOMIC_RELEASE, "agent");
            asm volatile("s_waitcnt vmcnt(0)" ::: "memory");
            const unsigned og = xb_add(&bar[XB_TOP], 1u);
            const unsigned tg = og / nx;
            if (og + 1u == (tg + 1u) * nx) xb_add(&bar[XB_TOPGEN], 1u);
            else XB_SPIN(xb_ld(&bar[XB_TOPGEN]) == tg, bar);
            __builtin_amdgcn_fence(__ATOMIC_ACQUIRE, "agent");
            asm volatile("buffer_inv sc0 sc1" ::: "memory");
            asm volatile("s_waitcnt vmcnt(0)" ::: "memory");
            xb_add(&bar[XB_XGEN(b.x)], 1u);
            asm volatile("s_waitcnt vmcnt(0)" ::: "memory");
        } else {
            XB_SPIN(xb_ld(&bar[XB_XGEN(b.x)]) == gen, bar);
            __builtin_amdgcn_fence(__ATOMIC_ACQUIRE, "agent");
            asm volatile("buffer_inv sc0 sc1" ::: "memory");
            asm volatile("s_waitcnt vmcnt(0)" ::: "memory");
        }
    }
    __syncthreads();
}

template <class FA, class FB, class FE>
__device__ __forceinline__ void ngemm(LAS float* sm, int M, int N, int K, int& tile_off, FA fa, FB fb, FE fe) {
    LAS float* As = sm;
    LAS float* Bs = sm + 16 * 65 + 15;
    Bs = sm + 1040;
    const int tid = threadIdx.x, ty = tid >> 4, tx = tid & 15, G = gridDim.x;
    const int tn = (N + 63) / 64, tm = (M + 63) / 64, tiles = tn * tm;
    int first = ((int)blockIdx.x - (tile_off % G) + G) % G;
    for (int t = first; t < tiles; t += G) {
        const int m0 = (t / tn) * 64, n0 = (t % tn) * 64;
        float acc[2][4];
#pragma unroll
        for (int i = 0; i < 2; ++i)
#pragma unroll
            for (int j = 0; j < 4; ++j) acc[i][j] = 0.f;
        for (int k0 = 0; k0 < K; k0 += 16) {
            __syncthreads();
#pragma unroll
            for (int j = 0; j < 2; ++j) {
                const int idx = tid + 512 * j;
                { const int m = idx >> 4, k = idx & 15; As[k * 65 + m] = (m0 + m < M) ? fa(m0 + m, k0 + k) : 0.f; }
                { const int k = idx >> 6, n = idx & 63; Bs[k * 64 + n] = (n0 + n < N) ? fb(k0 + k, n0 + n) : 0.f; }
            }
            __syncthreads();
#pragma unroll
            for (int k = 0; k < 16; ++k) {
                const float a0 = As[k * 65 + ty * 2], a1 = As[k * 65 + ty * 2 + 1];
                const f32x4 b = *(const LAS f32x4*)(Bs + k * 64 + tx * 4);
                acc[0][0] += a0 * b[0]; acc[0][1] += a0 * b[1]; acc[0][2] += a0 * b[2]; acc[0][3] += a0 * b[3];
                acc[1][0] += a1 * b[0]; acc[1][1] += a1 * b[1]; acc[1][2] += a1 * b[2]; acc[1][3] += a1 * b[3];
            }
        }
#pragma unroll
        for (int i = 0; i < 2; ++i)
#pragma unroll
            for (int j = 0; j < 4; ++j) { const int m = m0 + ty * 2 + i, n = n0 + tx * 4 + j; if (m < M && n < N) fe(m, n, acc[i][j]); }
    }
    tile_off += tiles;
}


#ifndef PG8_AUX
#define PG8_AUX 0
#endif
namespace pg8 {
#define PG8_LAS __attribute__((address_space(3)))
typedef unsigned short bf16_t;
typedef short bf16x8 __attribute__((ext_vector_type(8)));
typedef float f32x4 __attribute__((ext_vector_type(4)));
typedef unsigned u32x4 __attribute__((ext_vector_type(4)));
constexpr int BM = 256, BK = 64, HALF = 128, HTB = HALF * BK * 2  , STAGE_BYTES = 8 * HTB, NXCD = 8, WGM = 8;

__host__ __device__ __forceinline__ int lds_byte(int r, int c) { const int st = (r >> 4) * 2 + (c >> 5), rr = r & 15, cc = c & 31, ob = rr * 64 + cc * 2; return st * 1024 + (ob ^ (((ob >> 9) & 1) << 5)); }
__host__ __device__ __forceinline__ void stage_rc(int b, int& R, int& C) { const int st = b / 1024, sb = b % 1024, swz = sb ^ (((sb >> 9) & 1) << 5); R = (st >> 1) * 16 + swz / 64; C = (st & 1) * 32 + (swz % 64) / 2; }
__host__ __device__ __forceinline__ int perm32(int rho) { const int n = rho >> 4, i = rho & 15; return 8 * (i >> 2) + 4 * n + (i & 3); }

struct Unit { int pm, pn; };
struct Gemm { const bf16_t* A; const bf16_t* Bt; int M, N, K, lda, ldb; };

struct StaticOrder {
    int nM, nN, nwg, G, c;
    __host__ __device__ void init(int M, int N, int G_, int c_) { nM = M / BM; nN = N / BM; nwg = nM * nN; G = G_; c = c_; }
    __host__ __device__ bool next(int i, Unit& u) const {
        const long L = (long)i * G + c; if (L >= nwg) return false;
        int wgid = (int)L; { const int q = nwg / NXCD, r = nwg % NXCD, xcd = wgid % NXCD, off = wgid / NXCD; wgid = (xcd < r ? xcd * (q + 1) : r * (q + 1) + (xcd - r) * q) + off; }
        const int nig = WGM * nN, gid = wgid / nig, fm = gid * WGM, gsz = (nM - fm) < WGM ? (nM - fm) : WGM;
        u.pm = fm + ((wgid % nig) % gsz); u.pn = (wgid % nig) / gsz; return true;
    }
    __device__ __forceinline__ void a_ready(const Unit&) const {}
    __device__ __forceinline__ void done(const Unit&) const {}
};

__device__ __forceinline__ unsigned cvt_pk_bf16(float lo, float hi) { unsigned r; asm volatile("v_cvt_pk_bf16_f32 %0, %1, %2" : "=v"(r) : "v"(lo), "v"(hi)); return r; }

template <class Epi, class Sched, bool ALIGN_EPI = false, bool SP2 = false>
__device__ __forceinline__ void gemm_phase(PG8_LAS unsigned char* lds, const Gemm g, const Sched& S, const Epi& E) {
    const int tid = threadIdx.x, wid = __builtin_amdgcn_readfirstlane(tid >> 6), lane = tid & 63, wr = wid >> 2, wc = wid & 3, fr = lane & 15, fq = lane >> 4;
    const int K = g.K, nt = K / BK;
    unsigned voffA[2], voffB[2];
#pragma unroll
    for (int i = 0; i < 2; ++i) { int R, C; stage_rc(tid * 16 + i * 8192, R, C); const int Rb = Epi::PERM ? ((R & ~31) + perm32(R & 31)) : R;
        voffA[i] = (unsigned)(R * g.lda + C) * 2u; voffB[i] = (unsigned)(Rb * g.ldb + C) * 2u; }
    const size_t kstep = (size_t)(BK * 2);
    const size_t hstepA = (size_t)HALF * g.lda * 2, hstepB = (size_t)HALF * g.ldb * 2;
    const size_t tstepA = 2 * hstepA, tstepB = 2 * hstepB;
    const unsigned ldsw = (unsigned)wid * 1024u;
    const int aoff = lds_byte(wr * 64 + fr, fq * 8), boff = lds_byte(wc * 32 + fr, fq * 8);
#define PG8_SA(b, h) (((b) * 2 + (h)) * HTB)
#define PG8_SB(b, h) ((4 + (b) * 2 + (h)) * HTB)
#define PG8_STAGE(bufoff, gbase, voff) do { _Pragma("unroll") for (int _i = 0; _i < 2; ++_i) \
        __builtin_amdgcn_global_load_lds((const unsigned*)((const char*)(gbase) + (voff)[_i]), (PG8_LAS unsigned*)(lds + (bufoff) + ldsw + _i * 8192), 16, 0, PG8_AUX); } while (0)
#define PG8_LDA(dst, b, h) do { _Pragma("unroll") for (int m = 0; m < 4; ++m) _Pragma("unroll") for (int k = 0; k < 2; ++k) dst[m][k] = *(const PG8_LAS bf16x8*)(lds + PG8_SA(b, h) + aoff + m * 2048 + k * 1024); } while (0)
#define PG8_LDB(dst, b, h) do { _Pragma("unroll") for (int n = 0; n < 2; ++n) _Pragma("unroll") for (int k = 0; k < 2; ++k) dst[n][k] = *(const PG8_LAS bf16x8*)(lds + PG8_SB(b, h) + boff + n * 2048 + k * 1024); } while (0)
#define PG8_MMA(ai, bj, At, Bt) do { __builtin_amdgcn_s_setprio(1); _Pragma("unroll") for (int m = 0; m < 4; ++m) _Pragma("unroll") for (int n = 0; n < 2; ++n) _Pragma("unroll") for (int k = 0; k < 2; ++k) \
        acc[ai][bj][m][n] = __builtin_amdgcn_mfma_f32_16x16x32_bf16(Bt[n][k], At[m][k], acc[ai][bj][m][n], 0, 0, 0); __builtin_amdgcn_s_setprio(0); } while (0)
#define PG8_WAIT_V(n) asm volatile("s_waitcnt vmcnt(" #n ")" ::: "memory")
#define PG8_WAIT_L(n) asm volatile("s_waitcnt lgkmcnt(" #n ")" ::: "memory")
#define PG8_BAR __builtin_amdgcn_s_barrier()
#define PG8_SCHED __builtin_amdgcn_sched_barrier(0)
    Unit cur, nxt; int ui = 0;
    if (!S.next(0, cur)) return;
    f32x4 acc[2][2][4][2];
#pragma unroll
    for (int a = 0; a < 2; ++a)
#pragma unroll
        for (int b = 0; b < 2; ++b)
#pragma unroll
            for (int m = 0; m < 4; ++m)
#pragma unroll
                for (int n = 0; n < 2; ++n) acc[a][b][m][n] = (f32x4){0.f, 0.f, 0.f, 0.f};
    bf16x8 At[4][2], B0[2][2], B1[2][2];
    const char* cA = (const char*)g.A + (size_t)cur.pm * tstepA; const char* cB = (const char*)g.Bt + (size_t)cur.pn * tstepB;
    S.a_ready(cur);
    if constexpr (SP2) {
        PG8_STAGE(PG8_SB(0, 0), cB, voffB); PG8_STAGE(PG8_SB(0, 1), cB + hstepB, voffB); PG8_STAGE(PG8_SA(0, 0), cA, voffA); PG8_STAGE(PG8_SA(0, 1), cA + hstepA, voffA);
        if (wr == 1) PG8_BAR;
        PG8_WAIT_V(2); PG8_BAR;
        PG8_STAGE(PG8_SB(1, 0), cB + kstep, voffB); PG8_STAGE(PG8_SA(1, 0), cA + kstep, voffA); PG8_STAGE(PG8_SB(1, 1), cB + hstepB + kstep, voffB);
        PG8_WAIT_V(6); PG8_BAR;
    } else {
        PG8_STAGE(PG8_SB(0, 0), cB, voffB); PG8_STAGE(PG8_SA(0, 0), cA, voffA); PG8_STAGE(PG8_SB(0, 1), cB + hstepB, voffB); PG8_STAGE(PG8_SA(0, 1), cA + hstepA, voffA);
        if (wr == 1) PG8_BAR;
        PG8_WAIT_V(4); PG8_BAR;
        PG8_STAGE(PG8_SB(1, 0), cB + kstep, voffB); PG8_STAGE(PG8_SA(1, 0), cA + kstep, voffA); PG8_STAGE(PG8_SB(1, 1), cB + hstepB + kstep, voffB);
        PG8_WAIT_V(6); PG8_BAR;
    }
    for (;;) {
        const bool has_next = S.next(ui + 1, nxt);
        const char* nA = has_next ? (const char*)g.A + (size_t)nxt.pm * tstepA : cA; const char* nB = has_next ? (const char*)g.Bt + (size_t)nxt.pn * tstepB : cB;
#pragma unroll 1
        for (int t = 0; t < nt; t += 2) {
            const bool last = (t == nt - 2);
            const char* a1 = cA + (size_t)(t + 1) * kstep;
            const char* a2 = last ? nA : cA + (size_t)(t + 2) * kstep; const char* b2 = last ? nB : cB + (size_t)(t + 2) * kstep;
            const char* a3 = a2 + kstep; const char* b3 = b2 + kstep;
            if (last && has_next) S.a_ready(nxt);
            if constexpr (SP2) {
            PG8_LDB(B0, 0, 0); PG8_LDB(B1, 0, 1); PG8_SCHED; PG8_LDA(At, 0, 0); PG8_STAGE(PG8_SA(1, 1), a1 + hstepA, voffA);
            PG8_WAIT_V(8); PG8_WAIT_L(0); PG8_BAR; PG8_MMA(0, 0, At, B0); PG8_MMA(0, 1, At, B1); PG8_BAR; PG8_SCHED;
            PG8_LDA(At, 0, 1); PG8_STAGE(PG8_SB(0, 0), b2, voffB); PG8_STAGE(PG8_SB(0, 1), b2 + hstepB, voffB); PG8_STAGE(PG8_SA(0, 0), a2, voffA);
            PG8_WAIT_V(8); PG8_WAIT_L(0); PG8_BAR; PG8_MMA(1, 0, At, B0); PG8_MMA(1, 1, At, B1); PG8_BAR; PG8_SCHED;
            PG8_LDB(B0, 1, 0); PG8_LDB(B1, 1, 1); PG8_SCHED; PG8_LDA(At, 1, 0); PG8_STAGE(PG8_SA(0, 1), a2 + hstepA, voffA);
            PG8_WAIT_V(8); PG8_WAIT_L(0); PG8_BAR; PG8_MMA(0, 0, At, B0); PG8_MMA(0, 1, At, B1); PG8_BAR; PG8_SCHED;
            PG8_LDA(At, 1, 1); PG8_STAGE(PG8_SB(1, 0), b3, voffB); PG8_STAGE(PG8_SB(1, 1), b3 + hstepB, voffB); PG8_STAGE(PG8_SA(1, 0), a3, voffA);
            PG8_WAIT_V(8); PG8_WAIT_L(0); PG8_BAR; PG8_MMA(1, 0, At, B0); PG8_MMA(1, 1, At, B1); PG8_BAR; PG8_SCHED;
            } else {
            PG8_LDB(B0, 0, 0); PG8_SCHED; PG8_LDA(At, 0, 0); PG8_STAGE(PG8_SA(1, 1), a1 + hstepA, voffA);
            PG8_WAIT_L(8); PG8_BAR; PG8_WAIT_L(0); PG8_MMA(0, 0, At, B0); PG8_BAR; PG8_SCHED;
            PG8_LDB(B1, 0, 1); PG8_STAGE(PG8_SB(0, 0), b2, voffB);
            PG8_BAR; PG8_WAIT_L(0); PG8_MMA(0, 1, At, B1); PG8_BAR;
            PG8_LDA(At, 0, 1); PG8_STAGE(PG8_SA(0, 0), a2, voffA);
            PG8_BAR; PG8_WAIT_L(0); PG8_MMA(1, 0, At, B0); PG8_BAR; PG8_SCHED;
            PG8_STAGE(PG8_SB(0, 1), b2 + hstepB, voffB);
            PG8_WAIT_V(6); PG8_BAR; PG8_MMA(1, 1, At, B1); PG8_BAR;
            PG8_LDB(B0, 1, 0); PG8_SCHED; PG8_LDA(At, 1, 0); PG8_STAGE(PG8_SA(0, 1), a2 + hstepA, voffA);
            PG8_WAIT_L(8); PG8_BAR; PG8_WAIT_L(0); PG8_MMA(0, 0, At, B0); PG8_BAR; PG8_SCHED;
            PG8_LDB(B1, 1, 1); PG8_STAGE(PG8_SB(1, 0), b3, voffB);
            PG8_BAR; PG8_WAIT_L(0); PG8_MMA(0, 1, At, B1); PG8_BAR;
            PG8_LDA(At, 1, 1); PG8_STAGE(PG8_SA(1, 0), a3, voffA);
            PG8_BAR; PG8_WAIT_L(0); PG8_MMA(1, 0, At, B0); PG8_BAR; PG8_SCHED;
            PG8_STAGE(PG8_SB(1, 1), b3 + hstepB, voffB);
            PG8_WAIT_V(6); PG8_BAR; PG8_MMA(1, 1, At, B1); PG8_BAR;
            }
        }
        if constexpr (ALIGN_EPI) { if (wr == 0) PG8_BAR; }
        if constexpr (!Epi::AFTER_DRAIN) { E(acc, cur, wr, wc, fr, fq); S.done(cur); }
        if (!has_next) break;
#pragma unroll
        for (int a = 0; a < 2; ++a)
#pragma unroll
            for (int b = 0; b < 2; ++b)
#pragma unroll
                for (int m = 0; m < 4; ++m)
#pragma unroll
                    for (int n = 0; n < 2; ++n) acc[a][b][m][n] = (f32x4){0.f, 0.f, 0.f, 0.f};
        cur = nxt; cA = nA; cB = nB; ++ui;
        if constexpr (ALIGN_EPI) { if (wr == 1) PG8_BAR; }
    }
    PG8_WAIT_V(0);
    if constexpr (!ALIGN_EPI) { if (wr == 0) PG8_BAR; }
    PG8_BAR;
    if constexpr (Epi::AFTER_DRAIN) { E.fused(acc, cur, wr, wc, fr, fq, lds, wid, lane); S.done(cur); }
#undef PG8_SA
#undef PG8_SB
#undef PG8_STAGE
#undef PG8_LDA
#undef PG8_LDB
#undef PG8_MMA
#undef PG8_WAIT_V
#undef PG8_WAIT_L
#undef PG8_BAR
#undef PG8_SCHED
}
}

#define PG8_SP2 true
#define PG8_ALIGN true
namespace pg8 {
__device__ __forceinline__ void store8(bf16_t* p, f32x4 v0, f32x4 v1) { u32x4 w; w.x = cvt_pk_bf16(v0[0], v0[1]); w.y = cvt_pk_bf16(v0[2], v0[3]); w.z = cvt_pk_bf16(v1[0], v1[1]); w.w = cvt_pk_bf16(v1[2], v1[3]); *(u32x4*)p = w; }
__device__ __forceinline__ float sigm(float x) { return __builtin_amdgcn_rcpf(1.f + __builtin_amdgcn_exp2f(-1.4426950408889634f * x)); }
typedef unsigned u32x2 __attribute__((ext_vector_type(2)));
__device__ __forceinline__ void rope_store(bf16_t* p1, bf16_t* p2, f32x4 v0, f32x4 v1, f32x4 c, f32x4 s, float sc) {
    const float a0 = v0[0] * sc, b0 = v0[1] * sc, a1 = v0[2] * sc, b1 = v0[3] * sc, a2 = v1[0] * sc, b2 = v1[1] * sc, a3 = v1[2] * sc, b3 = v1[3] * sc;
    u32x2 o1, o2;
    o1.x = cvt_pk_bf16(a0 * c[0] - b0 * s[0], a1 * c[1] - b1 * s[1]); o1.y = cvt_pk_bf16(a2 * c[2] - b2 * s[2], a3 * c[3] - b3 * s[3]);
    o2.x = cvt_pk_bf16(b0 * c[0] + a0 * s[0], b1 * c[1] + a1 * s[1]); o2.y = cvt_pk_bf16(b2 * c[2] + a2 * s[2], b3 * c[3] + a3 * s[3]);
    *(u32x2*)p1 = o1; *(u32x2*)p2 = o2;
}
struct EpiStore {
    static constexpr bool PERM = true, AFTER_DRAIN = false;
    bf16_t* O; int ldc;
    __device__ __forceinline__ void operator()(const f32x4 (&acc)[2][2][4][2], const Unit& u, int wr, int wc, int fr, int fq) const {
        const int row0 = u.pm * BM + wr * 64 + fr, col0 = u.pn * BM + wc * 32 + 8 * fq;
#pragma unroll
        for (int ai = 0; ai < 2; ++ai)
#pragma unroll
            for (int m = 0; m < 4; ++m)
#pragma unroll
                for (int bj = 0; bj < 2; ++bj) store8(O + (size_t)(row0 + ai * HALF + m * 16) * ldc + col0 + bj * HALF, acc[ai][bj][m][0], acc[ai][bj][m][1]);
    }
};
struct EpiQ {
    static constexpr bool PERM = true, AFTER_DRAIN = false;
    bf16_t *qn, *qr; const float *rsq, *ropeC, *ropeS;
    __device__ __forceinline__ void operator()(const f32x4 (&acc)[2][2][4][2], const Unit& u, int wr, int wc, int fr, int fq) const {
        const int row0 = u.pm * BM + wr * 64 + fr;
        float rsv[2][4];
#pragma unroll
        for (int ai = 0; ai < 2; ++ai)
#pragma unroll
            for (int m = 0; m < 4; ++m) rsv[ai][m] = rsq[row0 + ai * HALF + m * 16] * QSCALE_MLA;
        if (u.pn < 4) {
            bf16_t* base = qn + u.pn * BM + wc * 32 + 8 * fq;
#pragma unroll
            for (int ai = 0; ai < 2; ++ai)
#pragma unroll
                for (int m = 0; m < 4; ++m) { const int row = row0 + ai * HALF + m * 16; const float rs = rsv[ai][m];
#pragma unroll
                    for (int bj = 0; bj < 2; ++bj) store8(base + (size_t)row * 1024 + bj * HALF, acc[ai][bj][m][0] * rs, acc[ai][bj][m][1] * rs); }
        } else {
#pragma unroll
            for (int bj = 0; bj < 2; ++bj) {
                const int cb = (u.pn - 4) * BM + bj * HALF + wc * 32 + 8 * fq, hd = cb >> 6, i0 = (cb & 63) >> 1;
                bf16_t* qb = qr + hd * 64 + i0;
#pragma unroll
                for (int ai = 0; ai < 2; ++ai)
#pragma unroll
                    for (int m = 0; m < 4; ++m) { const int row = row0 + ai * HALF + m * 16;
                        const f32x4 cc = *(const f32x4*)(ropeC + (size_t)row * 32 + i0), sn = *(const f32x4*)(ropeS + (size_t)row * 32 + i0);
                        rope_store(qb + (size_t)row * 512, qb + (size_t)row * 512 + 32, acc[ai][bj][m][0], acc[ai][bj][m][1], cc, sn, rsv[ai][m]);
                        asm volatile("" ::: "memory"); }
            }
        }
    }
};
struct EpiKV {
    static constexpr bool PERM = true, AFTER_DRAIN = false;
    bf16_t *kn, *vv; const float* rskv;
    __device__ __forceinline__ void operator()(const f32x4 (&acc)[2][2][4][2], const Unit& u, int wr, int wc, int fr, int fq) const {
        const int row0 = u.pm * BM + wr * 64 + fr; bf16_t* base = (u.pn < 4 ? kn + u.pn * BM : vv + (u.pn - 4) * BM) + wc * 32 + 8 * fq;
#pragma unroll
        for (int ai = 0; ai < 2; ++ai)
#pragma unroll
            for (int m = 0; m < 4; ++m) { const int row = row0 + ai * HALF + m * 16; const float rs = rskv[row];
#pragma unroll
                for (int bj = 0; bj < 2; ++bj) store8(base + (size_t)row * 1024 + bj * HALF, acc[ai][bj][m][0] * rs, acc[ai][bj][m][1] * rs); }
    }
};
template <int MODE> struct EpiGate {
    static constexpr bool PERM = true, AFTER_DRAIN = false;
    const bf16_t* gl; const float* gate_b; int goff; float* m32; bf16_t* merged;
    __device__ __forceinline__ void operator()(const f32x4 (&acc)[2][2][4][2], const Unit& u, int wr, int wc, int fr, int fq) const {
        const int row0 = u.pm * BM + wr * 64 + fr, col0 = u.pn * BM + wc * 32 + 8 * fq;
#pragma unroll
        for (int bj = 0; bj < 2; ++bj) { const int col = col0 + bj * HALF;
            const f32x4 b0 = *(const f32x4*)(gate_b + goff + col), b1 = *(const f32x4*)(gate_b + goff + col + 4);
#pragma unroll
            for (int ai = 0; ai < 2; ++ai)
#pragma unroll
                for (int m = 0; m < 4; ++m) { const size_t row = (size_t)(row0 + ai * HALF + m * 16);
                    const u32x4 gw = *(const u32x4*)(gl + row * 3072 + goff + col);
                    f32x4 g0, g1; g0[0] = __uint_as_float(gw.x << 16); g0[1] = __uint_as_float(gw.x & 0xffff0000u); g0[2] = __uint_as_float(gw.y << 16); g0[3] = __uint_as_float(gw.y & 0xffff0000u);
                    g1[0] = __uint_as_float(gw.z << 16); g1[1] = __uint_as_float(gw.z & 0xffff0000u); g1[2] = __uint_as_float(gw.w << 16); g1[3] = __uint_as_float(gw.w & 0xffff0000u);
                    g0 += b0; g1 += b1;
#pragma unroll
                    for (int j = 0; j < 4; ++j) { g0[j] = sigm(g0[j]); g1[j] = sigm(g1[j]); }
                    f32x4 v0 = acc[ai][bj][m][0] * g0, v1 = acc[ai][bj][m][1] * g1;
                    float* mp = m32 + row * 1024 + col;
                    if (MODE >= 1) { v0 += *(const f32x4*)mp; v1 += *(const f32x4*)(mp + 4); }
                    if (MODE <= 1) { *(f32x4*)mp = v0; *(f32x4*)(mp + 4) = v1; }
                    else store8(merged + row * 1024 + col, v0, v1); } }
    }
};
struct EpiRes {
    static constexpr bool PERM = false, AFTER_DRAIN = false;
    const float* x; float* x1;
    __device__ __forceinline__ void operator()(const f32x4 (&acc)[2][2][4][2], const Unit& u, int wr, int wc, int fr, int fq) const {
        const int row0 = u.pm * BM + wr * 64 + fr, col0 = u.pn * BM + wc * 32 + 4 * fq;
#pragma unroll
        for (int ai = 0; ai < 2; ++ai)
#pragma unroll
            for (int m = 0; m < 4; ++m) { const size_t off = (size_t)(row0 + ai * HALF + m * 16) * 1024 + col0;
#pragma unroll
                for (int bj = 0; bj < 2; ++bj)
#pragma unroll
                    for (int n = 0; n < 2; ++n) *(f32x4*)(x1 + off + bj * HALF + n * 16) = *(const f32x4*)(x + off + bj * HALF + n * 16) + acc[ai][bj][m][n]; }
    }
};
}


namespace fa {
typedef short bf16x8 __attribute__((ext_vector_type(8)));
typedef short s16x4 __attribute__((ext_vector_type(4)));
typedef float f32x16 __attribute__((ext_vector_type(16)));
typedef unsigned u32x4 __attribute__((ext_vector_type(4)));
__device__ __forceinline__ int crow(int r, int hi) { return (r & 3) + 8 * (r >> 2) + 4 * hi; }
__device__ __forceinline__ unsigned cvtpk(float lo, float hi) { unsigned r; asm volatile("v_cvt_pk_bf16_f32 %0, %1, %2" : "=v"(r) : "v"(lo), "v"(hi)); return r; }
__device__ __forceinline__ int v_rd_base(int lane) { return ((lane & 3) << 3) | (((lane >> 2) & 3) << 6) | (((lane >> 4) & 1) << 5) | (((lane >> 5) & 1) << 8); }
constexpr int v_rd_off(int d0, int ks, int half) { return d0 * 512 + ks * 4096 + half * 2048; }
template <int OFF> __device__ __forceinline__ s16x4 tr_read(int vb) { s16x4 r; asm volatile("ds_read_b64_tr_b16 %0, %1 offset:%2" : "=&v"(r) : "v"(vb), "i"(OFF) : "memory"); return r; }
template <int D0> __device__ __forceinline__ void pv_one(f32x16& od, int vb, bf16x8 pa0, bf16x8 pa1, bf16x8 pa2, bf16x8 pa3) {
    const s16x4 l0 = tr_read<v_rd_off(D0, 0, 0)>(vb), h0 = tr_read<v_rd_off(D0, 0, 1)>(vb), l1 = tr_read<v_rd_off(D0, 1, 0)>(vb), h1 = tr_read<v_rd_off(D0, 1, 1)>(vb);
    const s16x4 l2 = tr_read<v_rd_off(D0, 2, 0)>(vb), h2 = tr_read<v_rd_off(D0, 2, 1)>(vb), l3 = tr_read<v_rd_off(D0, 3, 0)>(vb), h3 = tr_read<v_rd_off(D0, 3, 1)>(vb);
    asm volatile("s_waitcnt lgkmcnt(0)" ::: "memory"); __builtin_amdgcn_sched_barrier(0);
#define FA_PK(L, H) (bf16x8){L[0], L[1], L[2], L[3], H[0], H[1], H[2], H[3]}
    od = __builtin_amdgcn_mfma_f32_32x32x16_bf16(pa0, FA_PK(l0, h0), od, 0, 0, 0);
    od = __builtin_amdgcn_mfma_f32_32x32x16_bf16(pa1, FA_PK(l1, h1), od, 0, 0, 0);
    od = __builtin_amdgcn_mfma_f32_32x32x16_bf16(pa2, FA_PK(l2, h2), od, 0, 0, 0);
    od = __builtin_amdgcn_mfma_f32_32x32x16_bf16(pa3, FA_PK(l3, h3), od, 0, 0, 0);
#undef FA_PK
}
template <int NQ, bool CAUSAL>
__device__ __forceinline__ void attn_block(const bf16* Qa, int ldqa, const bf16* Qb, int ldqb, const bf16* Ka, int ldka, const bf16* Kb, int ldkb,
                                           const bf16* V, int ldv, bf16* O, int ldo, int P0, int nkeys, LAS unsigned char* lds) {
    constexpr int KROWB = NQ * 32, SHM_K = 64 * KROWB, SHM_V = 64 * 256, NKI = SHM_K / 8192, NVI = 2;
    const int tid = threadIdx.x, wid = __builtin_amdgcn_readfirstlane(tid >> 6), lane = tid & 63, r32 = lane & 31, hi = lane >> 5;
    LAS unsigned char* K_lds = lds; LAS unsigned char* V_lds = lds + 2 * SHM_K;
    LAS float* wsf = (LAS float*)(lds + 2 * SHM_K + 2 * SHM_V) + wid * 64; LAS float* li_l = wsf; LAS float* al_l = wsf + 32;
    bf16x8 qr[NQ];
    { const bf16* qa = Qa + (size_t)(wid * 32 + r32) * ldqa + hi * 8;
#pragma unroll
      for (int d0 = 0; d0 < 8; ++d0) qr[d0] = *(const bf16x8*)(qa + d0 * 16);
      if constexpr (NQ == 12) { const bf16* qb = Qb + (size_t)(wid * 32 + r32) * ldqb + hi * 8;
#pragma unroll
          for (int d0 = 0; d0 < 4; ++d0) qr[8 + d0] = *(const bf16x8*)(qb + d0 * 16); } }
    int kso[NKI]; bool ksb[NKI]; int vso[NVI];
#pragma unroll
    for (int i = 0; i < NKI; ++i) { const int pch = i * 512 + tid, row = pch / (NQ * 2), cc = pch % (NQ * 2), sc = (cc & ~7) | ((cc & 7) ^ (row & 7));
        ksb[i] = (NQ == 12) && sc >= 16; kso[i] = ksb[i] ? row * ldkb + (sc - 16) * 8 : row * ldka + sc * 8; }
#pragma unroll
    for (int i = 0; i < NVI; ++i) { const int byte = (i * 512 + tid) * 16, sub = byte >> 9, within = byte & 511, kk = (sub >> 2) * 8 + (within >> 6), c = (sub & 3) * 32 + ((within & 63) >> 1);
        const int k = (kk & ~0xC) | ((kk & 4) << 1) | ((kk & 8) >> 1); vso[i] = k * ldv + c; }
    const int NT = CAUSAL ? (P0 + 256) / 64 : nkeys / 64;
    const unsigned ldsw = (unsigned)wid * 1024u;
#define FA_ISSUE(t_, buf_) do { const size_t kb_ = (size_t)(t_) * 64; \
        _Pragma("unroll") for (int i_ = 0; i_ < NKI; ++i_) { const bf16* src_ = ksb[i_] ? Kb + kb_ * ldkb + kso[i_] : Ka + kb_ * ldka + kso[i_]; \
            __builtin_amdgcn_global_load_lds((const unsigned*)src_, (LAS unsigned*)(K_lds + (buf_) * SHM_K + i_ * 8192 + ldsw), 16, 0, 0); } \
        _Pragma("unroll") for (int i_ = 0; i_ < NVI; ++i_) \
            __builtin_amdgcn_global_load_lds((const unsigned*)(V + kb_ * ldv + vso[i_]), (LAS unsigned*)(V_lds + (buf_) * SHM_V + i_ * 8192 + ldsw), 16, 0, 0); } while (0)
    float m_reg = -1e30f, l_reg = 0.f; f32x16 o[4];
#pragma unroll
    for (int d = 0; d < 4; ++d)
#pragma unroll
        for (int r = 0; r < 16; ++r) o[d][r] = 0.f;
    const int kbase_lane = KROWB * r32 + ((hi * 16) ^ ((r32 & 7) << 4));
    const int vb0 = (int)(unsigned)(size_t)(V_lds) + v_rd_base(lane);
    const int qpos = P0 + wid * 32 + r32;
    FA_ISSUE(0, 0);
    __syncthreads();
    for (int t = 0; t < NT; ++t) {
        const int buf = t & 1;
        if (t + 1 < NT) FA_ISSUE(t + 1, buf ^ 1);
        f32x16 p0, p1;
#pragma unroll
        for (int r = 0; r < 16; ++r) { p0[r] = 0.f; p1[r] = 0.f; }
        { LAS unsigned char* kt = K_lds + buf * SHM_K;
#pragma unroll
          for (int d0 = 0; d0 < NQ; ++d0) {
              const int off = (((d0 * 2) & ~7) << 4) + ((((d0 * 2) & 7) << 4 | (hi << 4)) ^ ((r32 & 7) << 4));
              const bf16x8 b0 = *(const LAS bf16x8*)(kt + KROWB * r32 + off), b1 = *(const LAS bf16x8*)(kt + KROWB * (32 + r32) + off);
              p0 = __builtin_amdgcn_mfma_f32_32x32x16_bf16(b0, qr[d0], p0, 0, 0, 0);
              p1 = __builtin_amdgcn_mfma_f32_32x32x16_bf16(b1, qr[d0], p1, 0, 0, 0); } }
        if (CAUSAL && t * 64 + 63 > P0 + wid * 32) {
            const int dq = qpos - t * 64 - 4 * hi; const float NEG = -__builtin_inff();
#pragma unroll
            for (int r = 0; r < 16; ++r) { const int c = (r & 3) + 8 * (r >> 2); if (dq - c < 0) p0[r] = NEG; if (dq - c - 32 < 0) p1[r] = NEG; }
        }
        float pmax = p0[0];
#pragma unroll
        for (int r = 1; r < 16; ++r) pmax = fmaxf(pmax, p0[r]);
#pragma unroll
        for (int r = 0; r < 16; ++r) pmax = fmaxf(pmax, p1[r]);
        { auto rr = __builtin_amdgcn_permlane32_swap(__float_as_uint(pmax), __float_as_uint(pmax), false, false); pmax = fmaxf(__uint_as_float(rr[0]), __uint_as_float(rr[1])); }
        float alpha = 1.f;
        if (!__all(pmax - m_reg <= 11.0f)) { const float mn = fmaxf(m_reg, pmax); alpha = __builtin_amdgcn_exp2f(m_reg - mn); m_reg = mn; }
        float ps = 0.f;
#pragma unroll
        for (int r = 0; r < 16; ++r) { p0[r] = __builtin_amdgcn_exp2f(p0[r] - m_reg); p1[r] = __builtin_amdgcn_exp2f(p1[r] - m_reg); ps += p0[r] + p1[r]; }
        { auto rr = __builtin_amdgcn_permlane32_swap(__float_as_uint(ps), __float_as_uint(ps), false, false); ps = __uint_as_float(rr[0]) + __uint_as_float(rr[1]); }
        l_reg = l_reg * alpha + ps;
        if (__any(alpha < 1.f)) { if (hi == 0) al_l[r32] = alpha; asm volatile("s_waitcnt lgkmcnt(0)" ::: "memory");
#pragma unroll
            for (int d = 0; d < 4; ++d)
#pragma unroll
                for (int r = 0; r < 16; ++r) o[d][r] *= al_l[crow(r, hi)];
            asm volatile("s_waitcnt lgkmcnt(0)" ::: "memory"); }
        bf16x8 pa0, pa1, pa2, pa3;
#define FA_PK4(P, B_, OUT) do { unsigned a0 = cvtpk(P[B_ + 0], P[B_ + 1]), a1 = cvtpk(P[B_ + 2], P[B_ + 3]); unsigned b0 = cvtpk(P[B_ + 4], P[B_ + 5]), b1 = cvtpk(P[B_ + 6], P[B_ + 7]); \
        auto r0 = __builtin_amdgcn_permlane32_swap(a0, b0, false, false); auto r1 = __builtin_amdgcn_permlane32_swap(a1, b1, false, false); \
        u32x4 w = {r0[0], r1[0], r0[1], r1[1]}; OUT = *reinterpret_cast<bf16x8*>(&w); } while (0)
        FA_PK4(p0, 0, pa0); FA_PK4(p0, 8, pa1); FA_PK4(p1, 0, pa2); FA_PK4(p1, 8, pa3);
#undef FA_PK4
        { const int vb = vb0 + buf * SHM_V;
          pv_one<0>(o[0], vb, pa0, pa1, pa2, pa3); pv_one<1>(o[1], vb, pa0, pa1, pa2, pa3); pv_one<2>(o[2], vb, pa0, pa1, pa2, pa3); pv_one<3>(o[3], vb, pa0, pa1, pa2, pa3); }
        __syncthreads();
    }
#undef FA_ISSUE
    if (hi == 0) li_l[r32] = l_reg; asm volatile("s_waitcnt lgkmcnt(0)" ::: "memory");
    bf16* Ow = O + (size_t)(wid * 32) * ldo;
#pragma unroll
    for (int r = 0; r < 16; ++r) { const int orow = crow(r, hi); const float rl = __builtin_amdgcn_rcpf(li_l[orow]);
#pragma unroll
        for (int d0 = 0; d0 < 4; ++d0) { const float v = o[d0][r] * rl; const float vn = __shfl_xor(v, 1);
            if ((r32 & 1) == 0) *(unsigned*)(Ow + (size_t)orow * ldo + d0 * 32 + r32) = cvtpk(v, vn); } }
    __syncthreads();
    (void)kbase_lane;
}
}
template <class SrcCol, class KScale>
__device__ __forceinline__ void tr_item(const float* W, int ldw, int K, bf16* WT, LAS float* scr, int item, int nblk, int lane, SrcCol srccol, KScale ksc, float csc = 1.f) {
    const int kb = item / nblk, nb = item % nblk, k0 = 64 * kb, n0 = 32 * nb;
    const int sc_ = srccol(n0 + (lane & 31));
#pragma unroll 8
    for (int i = 0; i < 32; ++i) { const int kk = 2 * i + (lane >> 5); scr[kk * 33 + (lane & 31)] = sc_ >= 0 ? W[(size_t)(k0 + kk) * ldw + sc_] * ksc(k0 + kk) * csc : 0.f; }
    asm volatile("s_waitcnt lgkmcnt(0)" ::: "memory");
    const int c = lane & 7;
#pragma unroll
    for (int j = 0; j < 4; ++j) { const int n = (lane >> 3) + 8 * j; const LAS float* sp = scr + (8 * c) * 33 + n;
        pg8::u32x4 o; o.x = pg8::cvt_pk_bf16(sp[0 * 33], sp[1 * 33]); o.y = pg8::cvt_pk_bf16(sp[2 * 33], sp[3 * 33]); o.z = pg8::cvt_pk_bf16(sp[4 * 33], sp[5 * 33]); o.w = pg8::cvt_pk_bf16(sp[6 * 33], sp[7 * 33]);
        *(pg8::u32x4*)(WT + (size_t)(n0 + n) * K + k0 + 8 * c) = o; }
    asm volatile("s_waitcnt lgkmcnt(0)" ::: "memory");
}

struct Args { const float* in[28]; float* out; unsigned char* ws; int ph_lo, ph_hi; };

constexpr int LDS_BYTES = 147456;
constexpr int N_PHASES = 13;

__global__ void __launch_bounds__(NTHREADS, 2) fwd(Args args) {
    extern __shared__ __attribute__((aligned(16))) unsigned char lds_raw[];
    LAS unsigned char* lds = (LAS unsigned char*)lds_raw;
    LAS float* sm = (LAS float*)lds;
    LAS float* wsm = (LAS float*)(lds + 16384);
    volatile LAS unsigned* MISC = (volatile LAS unsigned*)(lds + 131072 + 320);
    const int tid = threadIdx.x, lane = tid & 63, wave = tid >> 6, G = gridDim.x;
    const int gw = blockIdx.x * NWAVES + wave, NGW = G * NWAVES;
    unsigned char* ws = args.ws;
    unsigned* ctl = (unsigned*)(ws + WS_CTL);
    if (tid < 32) MISC[tid] = 0u;
    __syncthreads();
    XcdBarrier bar = xcd_barrier_post(ctl + CW_BAR, MISC + 8);
    const int lo = args.ph_lo, hi = args.ph_hi;
#define IN(k) (lo <= (k) && (k) < hi)
#ifndef PH_MASK
#define PH_MASK 0xffff
#endif
#define PHEN(k) (((PH_MASK) >> (k)) & 1)
#ifndef FASTMASK
#define FASTMASK 0x2c
#endif
#define FAST(k) (((FASTMASK) >> (k)) & 1)
#ifndef G1MASK
#define G1MASK 0x3f
#endif
#ifndef X2_DELAY_US
#define X2_DELAY_US 0
#define W1_TEST 0
#define DBL_BAR 1
#endif
#ifndef E6ORDER
#define E6ORDER 0
#endif
#define NG1(g) (E6ORDER || !FAST(0) || !(((G1MASK) >> (g)) & 1))
#define PH_LOCALS int tid = threadIdx.x; asm volatile("" : "+v"(tid)); const int lane = tid & 63, wave = __builtin_amdgcn_readfirstlane(tid >> 6), gw = blockIdx.x * NWAVES + wave; (void)lane; (void)gw;
#define SEAM(k) do { if (IN(k) && IN((k) + 1)) xcd_barrier(bar); } while (0)

#define xin (args.in[0])
#define memin (args.in[1])
#define mix_g (args.in[3])
#define w_in (args.in[4])
#define gate_b (args.in[5])
#define q_g (args.in[6])
#define w_uq (args.in[7])
#define kv_g (args.in[8])
#define w_uk (args.in[9])
#define w_uv (args.in[10])
#define pool_w (args.in[11])
#define pool_scale (args.in[12])
#define mem_g (args.in[13])
#define w_mem_kv (args.in[14])
#define w_br_pool (args.in[15])
#define w_br_mla (args.in[16])
#define w_br_mem (args.in[17])
#define w_out (args.in[18])
#define ffn_g (args.in[19])
#define w_rg (args.in[20])
#define b_rg (args.in[21])
#define w_re (args.in[22])
#define b_re (args.in[23])
#define w_gate_e (args.in[24])
#define w_up_e (args.in[25])
#define w_down_e (args.in[26])
#define final_g (args.in[27])
#define positions ((const int*)args.in[2])
#define ropeC ((float*)(ws + WS_ROPEC))
#define ropeS ((float*)(ws + WS_ROPES))
#define rsq ((float*)(ws + WS_RSQ))
#define rskv ((float*)(ws + WS_RSKV))
#define aw ((float*)(ws + WS_AW))
#define mkv ((bf16*)(ws + WS_MKV))
#define memn ((bf16*)(ws + WS_MEMN))
#define kr ((bf16*)(ws + WS_KR))
#define list ((int*)(ws + WS_LIST))
#define hb ((bf16*)(ws + WS_A))
#define qn ((bf16*)(ws + WS_A))
#define ymla ((bf16*)(ws + WS_A))
#define h2 ((bf16*)(ws + WS_A))
#define gates ((bf16*)(ws + WS_GATES))
#define hg ((float*)(ws + WS_HG))
#define hmid ((bf16*)(ws + WS_HMID))
#define pxq ((bf16*)(ws + WS_PXQ))
#define qkvd ((bf16*)(ws + WS_QKVD))
#define pp ((bf16*)(ws + WS_P))
#define qr ((bf16*)(ws + WS_QR))
#define merged ((bf16*)(ws + WS_MERGED))
#define yslot ((bf16*)(ws + WS_YSLOT))
#define kn ((bf16*)args.out)
#define vv ((bf16*)args.out + (size_t)T * D)
#define m32 (args.out)
#define x1 (args.out)
#define Wt_in ((bf16*)(ws + WS_WIN))
#define Wt_uq ((bf16*)(ws + WS_WUQ))
#define Wt_ukv ((bf16*)(ws + WS_WUKV))
#define Wt_out ((bf16*)(ws + WS_WOUT))
#define Wt_brmla ((bf16*)(ws + WS_WBRMLA))
#define Wt_memkv ((bf16*)(ws + WS_WMEMKV))
#define Wt_brpool ((bf16*)(ws + WS_WBRPOOL))
#define Wt_brmem ((bf16*)(ws + WS_WBRMEM))
    unsigned* cnt = ctl + CW_CNT;
    int toff = 0;

    if (PHEN(0) && IN(0)) {
        PH_LOCALS
        for (int r = gw; r < T + MROWS; r += NGW) {
            const bool is_x = r < T; const float* src = is_x ? xin + (size_t)r * D : memin + (size_t)(r - T) * D;
            const float* g = is_x ? mix_g : mem_g; bf16* dst = is_x ? hb + (size_t)r * D : memn + (size_t)(r - T) * D;
            float v[16]; float s = 0.f;
#pragma unroll
            for (int j = 0; j < 4; ++j) { const f32x4 q = *(const f32x4*)(src + j * 256 + lane * 4); v[4*j] = q[0]; v[4*j+1] = q[1]; v[4*j+2] = q[2]; v[4*j+3] = q[3]; s += q[0]*q[0] + q[1]*q[1] + q[2]*q[2] + q[3]*q[3]; }
            const float rs = 1.0f / sqrtf(wave_sum(s) * (1.f / D) + RMS_EPS);
#pragma unroll
            for (int j = 0; j < 4; ++j)
#pragma unroll
                for (int i = 0; i < 4; ++i) { const int c = j * 256 + lane * 4 + i; dst[c] = f2bf(v[4*j+i] * rs * g[c]); }
        }
        for (int i = blockIdx.x * NTHREADS + tid; i < T * 32; i += G * NTHREADS) {
            const int t = i >> 5, f = i & 31;
            const double inv = pow(10000.0, -(double)(2 * f) / 64.0);
            const float invf = (float)inv;
            const float ang = (float)positions[t] * invf;
            ropeC[i] = (float)cos((double)ang); ropeS[i] = (float)sin((double)ang);
        }
    }
    if (PHEN(0) && IN(0)) {
        PH_LOCALS
        LAS float* scr = (LAS float*)(lds + wave * 16384);
        constexpr int I_IN = 16 * (NPAD_IN / 32), I_UQ = 6 * 48, I_UKV = 4 * 64, I_SQ = 16 * 32, I_HALF = 8 * 32;
        constexpr int NIT = I_IN + I_UQ + I_UKV + 3 * I_SQ + 2 * I_HALF;
        auto one = [](int) { return 1.f; };
        for (int it = gw; it < NIT; it += NGW) {
            int r = it;
            if (r < I_IN) { const int nb = r % (NPAD_IN / 32);
                tr_item(w_in, DIN, 1024, Wt_in, scr, r, NPAD_IN / 32, lane, [](int n) {
                    if (n < 512) return n; if (n < 1024) return 1216 + (n - 512); if (n < 4096) return 1728 + (n - 1024); if (n < 4480) return 512 + (n - 4096);
                    if (n < 4736) return 896 + (n - 4480); if (n < 4800) return 1152 + (n - 4736); return -1; }, one, (nb >= 16 && nb < 32) ? QSCALE_MEM : 1.f); continue; } r -= I_IN;
            if (r < I_UQ) { const float* g = q_g; tr_item(w_uq, 1536, 384, Wt_uq, scr, r, 48, lane, [](int n) {
                    if (n < 1024) return (n >> 7) * 192 + (n & 127); const int q = n - 1024, hh = q >> 6, j = q & 63; return hh * 192 + 128 + (j >> 1) + 32 * (j & 1); }, [g](int k) { return g[k]; }); continue; } r -= I_UQ;
            if (r < I_UKV) { const float* g = kv_g; const int nb = r % 64;
                if (nb < 32) tr_item(w_uk, 1024, 256, Wt_ukv, scr, r, 64, lane, [](int n) { return n; }, [g](int k) { return g[k]; });
                else tr_item(w_uv - 1024, 1024, 256, Wt_ukv, scr, r, 64, lane, [](int n) { return n; }, [g](int k) { return g[k]; });
                continue; } r -= I_UKV;
            if (r < I_SQ) { tr_item(w_mem_kv, 1024, 1024, Wt_memkv, scr, r, 32, lane, [](int n) { return n; }, one); continue; } r -= I_SQ;
            if (r < I_SQ) { tr_item(w_br_mla, 1024, 1024, Wt_brmla, scr, r, 32, lane, [](int n) { return n; }, one); continue; } r -= I_SQ;
            if (r < I_SQ) { tr_item(w_out, 1024, 1024, Wt_out, scr, r, 32, lane, [](int n) { return n; }, one); continue; } r -= I_SQ;
            if (r < I_HALF) { tr_item(w_br_pool, 1024, 512, Wt_brpool, scr, r, 32, lane, [](int n) { return n; }, one); continue; } r -= I_HALF;
            tr_item(w_br_mem, 1024, 512, Wt_brmem, scr, r, 32, lane, [](int n) { return n; }, one);
        }
    }
    SEAM(0);
#if defined(X2_DELAY_US) && X2_DELAY_US > 0
    { const unsigned long long t0 = __builtin_amdgcn_s_memrealtime(); while (__builtin_amdgcn_s_memrealtime() - t0 < (unsigned long long)X2_DELAY_US * 100ull) __builtin_amdgcn_s_sleep(16); }
    __syncthreads();
#endif
    if (PHEN(1) && IN(1)) {
        PH_LOCALS
        { pg8::Gemm g{hb, Wt_in, T, 1024, 1024, 1024, 1024}; pg8::StaticOrder So; So.init(T, 1024, G, (int)blockIdx.x);
          pg8::EpiStore E{pxq, 1024};
          pg8::gemm_phase<pg8::EpiStore, pg8::StaticOrder, PG8_ALIGN, PG8_SP2>(lds, g, So, E); }
        { pg8::Gemm g{hb, Wt_in + (size_t)1024 * 1024, T, 3072, 1024, 1024, 1024}; pg8::StaticOrder So; So.init(T, 3072, G, (int)blockIdx.x);
          pg8::EpiStore E{gates, 3072};
          pg8::gemm_phase<pg8::EpiStore, pg8::StaticOrder, PG8_ALIGN, PG8_SP2>(lds, g, So, E); }
        { pg8::Gemm g{hb, Wt_in + (size_t)4096 * 1024, T, 768, 1024, 1024, 1024}; pg8::StaticOrder So; So.init(T, 768, G, (int)blockIdx.x);
          pg8::EpiStore E{qkvd, 768};
          pg8::gemm_phase<pg8::EpiStore, pg8::StaticOrder, PG8_ALIGN, PG8_SP2>(lds, g, So, E); }
        { pg8::Gemm g{memn, Wt_memkv, MROWS, 1024, 1024, 1024, 1024}; pg8::StaticOrder So; So.init(MROWS, 1024, G, ((int)blockIdx.x + G - 192) % G);
          pg8::EpiStore E{mkv, 1024};
          pg8::gemm_phase<pg8::EpiStore, pg8::StaticOrder, PG8_ALIGN, PG8_SP2>(lds, g, So, E); }
    }
    SEAM(1);
    if (PHEN(2) && IN(2)) {
        PH_LOCALS
        for (int t = gw; t < T; t += NGW) {
            const bf16* qk = qkvd + (size_t)t * 768;
            float s1 = 0.f;
#pragma unroll
            for (int j = 0; j < 6; ++j) { const float v = bf2f(qk[j * 64 + lane]); s1 += v * v; }
            s1 = wave_sum(s1);
            float s2 = 0.f;
#pragma unroll
            for (int j = 0; j < 4; ++j) { const float v = bf2f(qk[384 + j * 64 + lane]); s2 += v * v; }
            s2 = wave_sum(s2);
            if (lane == 0) { rsq[t] = 1.0f / sqrtf(s1 * (1.f / 384.f) + RMS_EPS); rskv[t] = 1.0f / sqrtf(s2 * (1.f / 256.f) + RMS_EPS); }
            if (lane < 32) {
                const float a = bf2f(qk[640 + lane]), b = bf2f(qk[672 + lane]), c = ropeC[t * 32 + lane], sn = ropeS[t * 32 + lane];
                kr[(size_t)t * 64 + lane] = f2bf(a * c - b * sn); kr[(size_t)t * 64 + 32 + lane] = f2bf(b * c + a * sn);
            }
            const int sidx = t & (S - 1);
#pragma unroll
            for (int j = 0; j < 8; ++j) {
                const int c = j * 64 + lane, g = c >> 7, w = 2 << g;
                const int n = (sidx + 1 < w) ? sidx + 1 : w;
                float sum = 0.f;
                for (int i = 0; i < n; ++i) sum += bf2f(pxq[(size_t)(t - i) * 1024 + c]);
                pp[(size_t)t * 512 + c] = f2bf(sum / (float)n - bf2f(pxq[(size_t)t * 1024 + c]));
            }
        }
    }
    SEAM(2);
    if (PHEN(3) && IN(3)) {
        PH_LOCALS
        { pg8::Gemm g{qkvd, Wt_uq, T, 1536, 384, 768, 384}; pg8::StaticOrder So; So.init(T, 1536, G, (int)blockIdx.x);
          pg8::EpiQ E{qn, qr, rsq, ropeC, ropeS};
          pg8::gemm_phase<pg8::EpiQ, pg8::StaticOrder, PG8_ALIGN, PG8_SP2>(lds, g, So, E); }
        { pg8::Gemm g{qkvd + 384, Wt_ukv, T, 2048, 256, 768, 256}; pg8::StaticOrder So; So.init(T, 2048, G, G - 1 - (int)blockIdx.x);
          pg8::EpiKV E{kn, vv, rskv};
          pg8::gemm_phase<pg8::EpiKV, pg8::StaticOrder, PG8_ALIGN, PG8_SP2>(lds, g, So, E); }
    }
    SEAM(3);
    if (PHEN(5) && IN(5) && FAST(5)) {
        for (int L = (int)blockIdx.x; L < 256; L += G) {
            const int bh = L >> 3, x = L & 7, b = bh >> 3, h = bh & 7;
#pragma unroll 1
            for (int pass = 0; pass < 2; ++pass) {
                const int qb = pass ? x : 15 - x; const size_t row0 = (size_t)b * S + (size_t)qb * 256, k0 = (size_t)b * S;
                fa::attn_block<12, true>(qn + row0 * 1024 + h * 128, 1024, qr + row0 * 512 + h * 64, 512, kn + k0 * 1024 + h * 128, 1024, kr + k0 * 64, 64,
                                         vv + k0 * 1024 + h * 128, 1024, ymla + row0 * 1024 + h * 128, 1024, qb * 256, S, lds);
            }
        }
        for (int L = (int)blockIdx.x; L < 256; L += G) {
            const int b = L >> 6, h = (L >> 4) & 3, qb = L & 15; const size_t row0 = (size_t)b * S + (size_t)qb * 256, k0 = (size_t)b * MEMLEN;
            fa::attn_block<8, false>(pxq + row0 * 1024 + 512 + h * 128, 1024, nullptr, 0, mkv + k0 * 1024 + h * 128, 1024, nullptr, 0,
                                     mkv + k0 * 1024 + 512 + h * 128, 1024, pxq + row0 * 1024 + 512 + h * 128, 1024, 0, MEMLEN, lds);
        }
    }
    if (PHEN(5) && IN(5) && !FAST(5)) {
        PH_LOCALS
        LAS float* qs = wsm + wave * 256;
        for (int task = gw; task < T * 8; task += NGW) {
            const int t = task >> 3, hh = task & 7, b = t >> 12, sidx = t & (S - 1);
            qs[lane] = bf2f(qn[(size_t)t * 1024 + hh * 128 + lane]); qs[64 + lane] = bf2f(qn[(size_t)t * 1024 + hh * 128 + 64 + lane]);
            qs[128 + lane] = bf2f(qr[(size_t)t * 512 + hh * 64 + lane]);
            asm volatile("s_waitcnt lgkmcnt(0)" ::: "memory");
            float m_run = -1e30f, l_run = 0.f, o0 = 0.f, o1 = 0.f;
            for (int j0 = 0; j0 <= sidx; j0 += 64) {
                asm volatile("" ::: "memory");
                const int key = j0 + lane; const bool valid = key <= sidx; const size_t kt = (size_t)(b * S + (valid ? key : sidx));
                float sc = 0.f;
                const bf16* kp = kn + kt * 1024 + hh * 128;
#pragma unroll 2
                for (int k = 0; k < 128; k += 8) { const uint4 w = *(const uint4*)(kp + k); const unsigned ww[4] = {w.x, w.y, w.z, w.w};
#pragma unroll
                    for (int i = 0; i < 4; ++i) { sc += qs[k + 2*i] * __uint_as_float(ww[i] << 16) + qs[k + 2*i + 1] * __uint_as_float(ww[i] & 0xffff0000u); } }
                const bf16* rp = kr + kt * 64;
#pragma unroll 2
                for (int k = 0; k < 64; k += 8) { const uint4 w = *(const uint4*)(rp + k); const unsigned ww[4] = {w.x, w.y, w.z, w.w};
#pragma unroll
                    for (int i = 0; i < 4; ++i) { sc += qs[128 + k + 2*i] * __uint_as_float(ww[i] << 16) + qs[128 + k + 2*i + 1] * __uint_as_float(ww[i] & 0xffff0000u); } }
                if (!valid) sc = -1e30f;
                const float mn = fmaxf(m_run, wave_max(sc));
                const float alpha = exp2f(m_run - mn);
                const float p = valid ? exp2f(sc - mn) : 0.f;
                l_run = l_run * alpha + wave_sum(p); o0 *= alpha; o1 *= alpha; m_run = mn;
                const int nk = (sidx - j0 + 1 < 64) ? sidx - j0 + 1 : 64;
                for (int j = 0; j < nk; ++j) {
                    const float pj = __shfl(p, j);
                    const unsigned w = *(const unsigned*)(vv + (size_t)(b * S + j0 + j) * 1024 + hh * 128 + lane * 2);
                    o0 += pj * __uint_as_float(w << 16); o1 += pj * __uint_as_float(w & 0xffff0000u);
                }
            }
            const float il = 1.f / l_run;
            *(unsigned*)(ymla + (size_t)t * 1024 + hh * 128 + lane * 2) = (unsigned)f2bf(o0 * il) | ((unsigned)f2bf(o1 * il) << 16);
        }
        for (int task = gw; task < T * 4; task += NGW) {
            const int t = task >> 2, hh = task & 3, b = t >> 12;
            qs[lane] = bf2f(pxq[(size_t)t * 1024 + 512 + hh * 128 + lane]); qs[64 + lane] = bf2f(pxq[(size_t)t * 1024 + 512 + hh * 128 + 64 + lane]);
            asm volatile("s_waitcnt lgkmcnt(0)" ::: "memory");
            float m_run = -1e30f, l_run = 0.f, o0 = 0.f, o1 = 0.f;
            for (int j0 = 0; j0 < MEMLEN; j0 += 64) {
                asm volatile("" ::: "memory");
                const size_t kt = (size_t)(b * MEMLEN + j0 + lane);
                float sc = 0.f;
                const bf16* kp = mkv + kt * 1024 + hh * 128;
#pragma unroll 2
                for (int k = 0; k < 128; k += 8) { const uint4 w = *(const uint4*)(kp + k); const unsigned ww[4] = {w.x, w.y, w.z, w.w};
#pragma unroll
                    for (int i = 0; i < 4; ++i) { sc += qs[k + 2*i] * __uint_as_float(ww[i] << 16) + qs[k + 2*i + 1] * __uint_as_float(ww[i] & 0xffff0000u); } }
                const float mn = fmaxf(m_run, wave_max(sc));
                const float alpha = exp2f(m_run - mn);
                const float p = exp2f(sc - mn);
                l_run = l_run * alpha + wave_sum(p); o0 *= alpha; o1 *= alpha; m_run = mn;
                for (int j = 0; j < 64; ++j) {
                    const float pj = __shfl(p, j);
                    const unsigned w = *(const unsigned*)(mkv + (size_t)(b * MEMLEN + j0 + j) * 1024 + 512 + hh * 128 + lane * 2);
                    o0 += pj * __uint_as_float(w << 16); o1 += pj * __uint_as_float(w & 0xffff0000u);
                }
            }
            const float il = 1.f / l_run;
            *(unsigned*)(pxq + (size_t)t * 1024 + 512 + hh * 128 + lane * 2) = (unsigned)f2bf(o0 * il) | ((unsigned)f2bf(o1 * il) << 16);
        }
    }
    SEAM(5);
    if (PHEN(6) && IN(6)) {
        PH_LOCALS
        for (int g = 0; g < 4; ++g)
            ngemm(sm, T, 128, 128, toff,
                  [&](int m, int k) { return bf2f(pp[(size_t)m * 512 + g * 128 + k]); },
                  [&](int k, int n) { return pool_w[(size_t)g * 16384 + k * 128 + n]; },
                  [&](int m, int n, float a) { pxq[(size_t)m * 1024 + g * 128 + n] = f2bf(a * pool_scale[g * 128 + n]); });
    }
    SEAM(6);
    if (PHEN(7) && IN(7)) {
        PH_LOCALS
        if (FAST(2)) {
        pg8::StaticOrder So; So.init(T, 1024, G, (int)blockIdx.x);
        { pg8::Gemm g{pxq, Wt_brpool, T, 1024, 512, 1024, 512}; pg8::EpiGate<0> E{gates, gate_b, 0, m32, merged};
          pg8::gemm_phase<pg8::EpiGate<0>, pg8::StaticOrder, PG8_ALIGN, PG8_SP2>(lds, g, So, E); }
        { pg8::Gemm g{ymla, Wt_brmla, T, 1024, 1024, 1024, 1024}; pg8::EpiGate<1> E{gates, gate_b, 1024, m32, merged};
          pg8::gemm_phase<pg8::EpiGate<1>, pg8::StaticOrder, PG8_ALIGN, PG8_SP2>(lds, g, So, E); }
        { pg8::Gemm g{pxq + 512, Wt_brmem, T, 1024, 512, 1024, 512}; pg8::EpiGate<2> E{gates, gate_b, 2048, m32, merged};
          pg8::gemm_phase<pg8::EpiGate<2>, pg8::StaticOrder, PG8_ALIGN, PG8_SP2>(lds, g, So, E); }
        } else {
        auto gate = [&](int m, int j) { return 1.f / (1.f + __expf(-(bf2f(gates[(size_t)m * 3072 + j]) + gate_b[j]))); };
        int to = toff;
        ngemm(sm, T, D, 512, to,
              [&](int m, int k) { return bf2f(pxq[(size_t)m * 1024 + k]); },
              [&](int k, int n) { return w_br_pool[(size_t)k * D + n]; },
              [&](int m, int n, float a) { m32[(size_t)m * D + n] = a * gate(m, n); });
        to = toff;
        ngemm(sm, T, D, 1024, to,
              [&](int m, int k) { return bf2f(ymla[(size_t)m * 1024 + k]); },
              [&](int k, int n) { return w_br_mla[(size_t)k * D + n]; },
              [&](int m, int n, float a) { m32[(size_t)m * D + n] += a * gate(m, 1024 + n); });
        to = toff;
        ngemm(sm, T, D, 512, to,
              [&](int m, int k) { return bf2f(pxq[(size_t)m * 1024 + 512 + k]); },
              [&](int k, int n) { return w_br_mem[(size_t)k * D + n]; },
              [&](int m, int n, float a) { merged[(size_t)m * D + n] = f2bf(m32[(size_t)m * D + n] + a * gate(m, 2048 + n)); });
        toff = to;
        }
    }
    SEAM(7);
    if (PHEN(8) && IN(8)) {
        PH_LOCALS
        if (FAST(3)) {
        pg8::Gemm g{merged, Wt_out, T, 1024, 1024, 1024, 1024}; pg8::StaticOrder So; So.init(T, 1024, G, (int)blockIdx.x);
        pg8::EpiRes E{xin, x1};
        pg8::gemm_phase<pg8::EpiRes, pg8::StaticOrder, PG8_ALIGN, PG8_SP2>(lds, g, So, E);
        } else {
        ngemm(sm, T, D, D, toff,
              [&](int m, int k) { return bf2f(merged[(size_t)m * D + k]); },
              [&](int k, int n) { return w_out[(size_t)k * D + n]; },
              [&](int m, int n, float a) { x1[(size_t)m * D + n] = xin[(size_t)m * D + n] + a; });
        }
    }
    SEAM(8);
    if (PHEN(9) && IN(9)) {
        PH_LOCALS
        for (int t = gw; t < T; t += NGW) {
            float s = 0.f;
#pragma unroll
            for (int j = 0; j < 4; ++j) { const f32x4 q = *(const f32x4*)(x1 + (size_t)t * D + j * 256 + lane * 4); s += q[0]*q[0] + q[1]*q[1] + q[2]*q[2] + q[3]*q[3]; }
            const float rs = 1.0f / sqrtf(wave_sum(s) * (1.f / D) + RMS_EPS);
            float lg[36];
#pragma unroll
            for (int c = 0; c < 36; ++c) lg[c] = 0.f;
#pragma unroll 1
            for (int j = 0; j < 4; ++j) {
                const f32x4 q = *(const f32x4*)(x1 + (size_t)t * D + j * 256 + lane * 4);
                const f32x4 gq = *(const f32x4*)(ffn_g + j * 256 + lane * 4);
#pragma unroll
                for (int i = 0; i < 4; ++i) { const int k = j * 256 + lane * 4 + i; const float hv = q[i] * rs * gq[i];
                    h2[(size_t)t * D + k] = f2bf(hv);
                    const f32x4 wg = *(const f32x4*)(w_rg + (size_t)k * 4);
                    lg[0] += hv * wg[0]; lg[1] += hv * wg[1]; lg[2] += hv * wg[2]; lg[3] += hv * wg[3];
#pragma unroll
                    for (int c4 = 0; c4 < 8; ++c4) { const f32x4 we = *(const f32x4*)(w_re + (size_t)k * 32 + c4 * 4);
                        lg[4 + c4*4] += hv * we[0]; lg[5 + c4*4] += hv * we[1]; lg[6 + c4*4] += hv * we[2]; lg[7 + c4*4] += hv * we[3]; } }
            }
#pragma unroll
            for (int c = 0; c < 36; ++c) lg[c] = wave_sum(lg[c]);
            int gi = 0; float gmax = lg[0] + b_rg[0];
#pragma unroll
            for (int c = 1; c < 4; ++c) { const float l = lg[c] + b_rg[c]; if (l > gmax) { gmax = l; gi = c; } }
            float gden = 0.f;
#pragma unroll
            for (int c = 0; c < 4; ++c) gden += __expf(lg[c] + b_rg[c] - gmax);
            const float p_g = 1.f / gden;
            float el[8];
#pragma unroll
            for (int c = 0; c < 8; ++c) { float val = 0.f;
#pragma unroll
                for (int g2 = 0; g2 < 4; ++g2) val = (gi == g2) ? lg[4 + g2 * 8 + c] + b_re[g2 * 8 + c] : val;
                el[c] = val; }
            int i1 = 0; float l1 = el[0];
#pragma unroll
            for (int c = 1; c < 8; ++c) if (el[c] > l1) { l1 = el[c]; i1 = c; }
            int i2 = -1; float l2 = -3.0e38f;
#pragma unroll
            for (int c = 0; c < 8; ++c) if (c != i1 && el[c] > l2) { l2 = el[c]; i2 = c; }
            const float r = __expf(l2 - l1);
            const float w1 = p_g / (1.f + r), w2 = p_g * r / (1.f + r);
            if (lane == 0) {
                const int e1 = gi * 8 + i1, e2 = gi * 8 + i2;
                const unsigned p1 = atomicAdd(&cnt[e1], 1u); list[e1 * T + p1] = t * 2;
                const unsigned p2 = atomicAdd(&cnt[e2], 1u); list[e2 * T + p2] = t * 2 + 1;
                aw[t * 2] = w1; aw[t * 2 + 1] = w2;
            }
        }
    }
    SEAM(9);
    if (PHEN(10) && IN(10)) {
        PH_LOCALS
        int base = 0;
        for (int e = 0; e < NE; ++e) {
            const int ne = (int)cnt[e]; const int* le = list + e * T;
            const float* wg = w_gate_e + (size_t)e * D * DE; const float* wu = w_up_e + (size_t)e * D * DE;
            int to = toff;
            ngemm(sm, ne, DE, D, to,
                  [&](int m, int k) { return bf2f(h2[(size_t)(le[m] >> 1) * D + k]); },
                  [&](int k, int n) { return wg[(size_t)k * DE + n]; },
                  [&](int m, int n, float a) { hg[(size_t)(base + m) * DE + n] = a; });
            to = toff;
            ngemm(sm, ne, DE, D, to,
                  [&](int m, int k) { return bf2f(h2[(size_t)(le[m] >> 1) * D + k]); },
                  [&](int k, int n) { return wu[(size_t)k * DE + n]; },
                  [&](int m, int n, float a) { const float gg = hg[(size_t)(base + m) * DE + n]; hmid[(size_t)(base + m) * DE + n] = f2bf(gg / (1.f + __expf(-gg)) * a); });
            toff = to; base += ne;
        }
    }
    SEAM(10);
    if (PHEN(11) && IN(11)) {
        PH_LOCALS
        int base = 0;
        for (int e = 0; e < NE; ++e) {
            const int ne = (int)cnt[e]; const int* le = list + e * T;
            const float* wd = w_down_e + (size_t)e * DE * D;
            ngemm(sm, ne, D, DE, toff,
                  [&](int m, int k) { return bf2f(hmid[(size_t)(base + m) * DE + k]); },
                  [&](int k, int n) { return wd[(size_t)k * D + n]; },
                  [&](int m, int n, float a) { const int as = le[m]; yslot[(size_t)as * D + n] = f2bf(aw[as] * a); });
            base += ne;
        }
    }
    SEAM(11);
    if (PHEN(12) && IN(12)) {
        PH_LOCALS
        for (int t = gw; t < T; t += NGW) {
            float v[16]; float s = 0.f;
#pragma unroll
            for (int j = 0; j < 4; ++j) { const int c = j * 256 + lane * 4; const f32x4 q = *(const f32x4*)(x1 + (size_t)t * D + c);
                const uint2 y0 = *(const uint2*)(yslot + (size_t)(2 * t) * D + c), y1 = *(const uint2*)(yslot + (size_t)(2 * t + 1) * D + c);
                v[4*j]   = q[0] + __uint_as_float(y0.x << 16) + __uint_as_float(y1.x << 16);
                v[4*j+1] = q[1] + __uint_as_float(y0.x & 0xffff0000u) + __uint_as_float(y1.x & 0xffff0000u);
                v[4*j+2] = q[2] + __uint_as_float(y0.y << 16) + __uint_as_float(y1.y << 16);
                v[4*j+3] = q[3] + __uint_as_float(y0.y & 0xffff0000u) + __uint_as_float(y1.y & 0xffff0000u);
                s += v[4*j]*v[4*j] + v[4*j+1]*v[4*j+1] + v[4*j+2]*v[4*j+2] + v[4*j+3]*v[4*j+3]; }
            const float rs = 1.0f / sqrtf(wave_sum(s) * (1.f / D) + RMS_EPS);
#pragma unroll
            for (int j = 0; j < 4; ++j) { const int c = j * 256 + lane * 4; const f32x4 g = *(const f32x4*)(final_g + c);
                f32x4 o; o[0] = v[4*j] * rs * g[0]; o[1] = v[4*j+1] * rs * g[1]; o[2] = v[4*j+2] * rs * g[2]; o[3] = v[4*j+3] * rs * g[3];
                *(f32x4*)(args.out + (size_t)t * D + c) = o; }
        }
    }
#undef IN
#undef SEAM
}

extern "C" void kernel_launch(void* const* d_in, const int* in_sizes, int n_in, void* d_out, int out_size, void* d_ws, size_t ws_size, hipStream_t stream) {
    static int grid = 0;
    if (grid == 0) {
        if (n_in != 28 || out_size != T * D || ws_size < WS_END) { fprintf(stderr, "kernel_launch: unexpected shapes n_in %d out %d ws %zu\n", n_in, out_size, ws_size); grid = -1; return; }
        int dev = 0, cus = 0, per_cu = 0;
        if (hipGetDevice(&dev) != hipSuccess || hipDeviceGetAttribute(&cus, hipDeviceAttributeMultiprocessorCount, dev) != hipSuccess) { grid = -1; return; }
        if (hipFuncSetAttribute((const void*)fwd, hipFuncAttributeMaxDynamicSharedMemorySize, LDS_BYTES) != hipSuccess) { fprintf(stderr, "hipFuncSetAttribute failed\n"); grid = -1; return; }
        if (hipOccupancyMaxActiveBlocksPerMultiprocessor(&per_cu, (const void*)fwd, NTHREADS, LDS_BYTES) != hipSuccess || per_cu < 1) fprintf(stderr, "occupancy query: %d\n", per_cu);
        (void)hipGetLastError();
        grid = cus;
    }
    if (grid < 0) return;
    (void)hipMemsetAsync((char*)d_ws + WS_CTL, 0, CTL_ZERO_BYTES, stream);
    Args a{};
    for (int i = 0; i < 28; ++i) a.in[i] = (const float*)d_in[i];
    a.out = (float*)d_out; a.ws = (unsigned char*)d_ws; a.ph_lo = 0; a.ph_hi = N_PHASES;
    hipLaunchKernelGGL(fwd, dim3(grid), dim3(NTHREADS), LDS_BYTES, stream, a);
}
```

```cpp
#include <hip/hip_runtime.h>
#include <cstdio>
#include <cstdint>

#define LAS __attribute__((address_space(3)))
typedef unsigned short bf16;
typedef float f32x4 __attribute__((ext_vector_type(4)));

constexpr int NB = 4, S = 4096, T = NB * S, D = 1024, DIN = 4800, MEMLEN = 256, MROWS = NB * MEMLEN;
constexpr int NE = 32, DE = 256;
constexpr float RMS_EPS = 1e-6f;
constexpr int NWAVES = 8, NTHREADS = 512;
constexpr float QSCALE_MLA = 0.07216878364870322f * 1.4426950408889634f;
constexpr float QSCALE_MEM = 0.08838834764831845f * 1.4426950408889634f;

constexpr size_t MiB = 1u << 20;
constexpr size_t WS_CTL = 0, CTL_ZERO_BYTES = 1 * MiB;
constexpr size_t KiB = 1u << 10;
constexpr size_t WS_ROPEC = 1 * MiB, WS_ROPES = 3 * MiB, WS_RSQ = 5 * MiB, WS_RSKV = 5 * MiB + 64 * KiB, WS_AW = 6 * MiB + 768 * KiB;
constexpr size_t WS_MKV = 7 * MiB, WS_MEMN = 9 * MiB, WS_KR = 11 * MiB, WS_LIST = 13 * MiB, WS_WBRMEM = 15 * MiB;
constexpr size_t WS_WIN = 224 * MiB;
constexpr size_t WS_WUQ = 240 * MiB, WS_WUKV = WS_WUQ + 1152 * KiB, WS_WOUT = WS_WUKV + 1 * MiB, WS_WBRMLA = WS_WOUT + 2 * MiB,
                 WS_WMEMKV = WS_WBRMLA + 2 * MiB, WS_WBRPOOL = WS_WMEMKV + 2 * MiB;
static_assert(WS_WBRPOOL + 1 * MiB <= 256 * MiB, "weights fit");
constexpr int NPAD_IN = 4864;
constexpr size_t WS_A = 24 * MiB;
constexpr size_t WS_GATES = 56 * MiB;
constexpr size_t WS_HG = 56 * MiB, WS_HMID = 88 * MiB;
constexpr size_t WS_WGU = 56 * MiB, WS_WD = 88 * MiB, WS_HMID2 = 104 * MiB;
constexpr int TAB_OFF = 131072 + 1024;
constexpr size_t WS_PXQ = 152 * MiB;
constexpr size_t WS_QKVD = 184 * MiB;
constexpr size_t WS_QR = 208 * MiB;
constexpr size_t WS_P = 224 * MiB;
constexpr size_t WS_MERGED = 184 * MiB;
constexpr size_t WS_YSLOT = 152 * MiB;
constexpr size_t WS_END = 256 * MiB;
constexpr int CW_BAR = 4096, CW_CNT = 1024;

__device__ __forceinline__ float bf2f(bf16 v) { return __uint_as_float(((unsigned)v) << 16); }
__device__ __forceinline__ bf16 f2bf(float f) { unsigned u = __float_as_uint(f); u += 0x7fffu + ((u >> 16) & 1u); return (bf16)(u >> 16); }
__device__ __forceinline__ float wave_sum(float v) {
#pragma unroll
    for (int o = 1; o < 64; o <<= 1) v += __shfl_xor(v, o);
    return v;
}
__device__ __forceinline__ float wave_max(float v) {
#pragma unroll
    for (int o = 1; o < 64; o <<= 1) v = fmaxf(v, __shfl_xor(v, o));
    return v;
}

#define XB_TMO      128
#define XB_XCNT(j)  (256  + 64 * (j))
#define XB_XSUB(j)  (1280 + 64 * (j))
#define XB_XGEN(j)  (2304 + 64 * (j))
#define XB_TOP      3328
#define XB_TOPGEN   3392
#define XCD_BAR_WORDS 3456
#define XB_SPIN_CAP (1u << 18)

__device__ __forceinline__ unsigned xb_ld(unsigned* p)              { return __hip_atomic_load(p, __ATOMIC_RELAXED, __HIP_MEMORY_SCOPE_AGENT); }
__device__ __forceinline__ unsigned xb_add(unsigned* p, unsigned v) { return __hip_atomic_fetch_add(p, v, __ATOMIC_RELAXED, __HIP_MEMORY_SCOPE_AGENT); }
__device__ __forceinline__ unsigned xb_xcc_id() { return (unsigned)__builtin_amdgcn_s_getreg((3 << 11) | 20) & 0xFu; }
#define XB_SPIN(cond, bar) do { unsigned _sp = 0; while (cond) { __builtin_amdgcn_s_sleep(1); \
    if ((++_sp & 255u) == 0u) { if (xb_ld(&(bar)[XB_TMO])) break; if (_sp > XB_SPIN_CAP) { atomicAdd(&(bar)[XB_TMO], 1u); break; } } } } while (0)

struct XcdBarrier { unsigned* bar; unsigned x; volatile LAS unsigned* st; };

__device__ __forceinline__ XcdBarrier xcd_barrier_post(unsigned* bar, volatile LAS unsigned* st) {
    XcdBarrier b; b.bar = bar; b.x = xb_xcc_id(); b.st = st;
    if (threadIdx.x == 0) (void)xb_add(&bar[XB_XCNT(b.x)], 1u);
    return b;
}
__device__ __forceinline__ void xcd_barrier_complete(unsigned* bar, unsigned x, unsigned& nloc, unsigned& nx) {
    const unsigned G = gridDim.x * gridDim.y * gridDim.z;
    unsigned sum, cnt, mine, sp = 0u;
    for (;;) {
        sum = 0u; cnt = 0u; mine = 0u;
#pragma unroll
        for (unsigned j = 0; j < 16; ++j) { const unsigned c = xb_ld(&bar[XB_XCNT(j)]); sum += c; cnt += (c > 0u) ? 1u : 0u; mine = (j == x) ? c : mine; }
        if (sum == G) break;
        __builtin_amdgcn_s_sleep(1);
        if ((++sp & 255u) == 0u) { if (xb_ld(&bar[XB_TMO])) break; if (sp > XB_SPIN_CAP) { atomicAdd(&bar[XB_TMO], 1u); break; } }
    }
    nloc = mine > 0u ? mine : 1u; nx = cnt > 0u ? cnt : 1u;
}
__device__ __forceinline__ void xcd_barrier(const XcdBarrier& b) {
    asm volatile("s_waitcnt vmcnt(0)" ::: "memory");
    __syncthreads();
    if (threadIdx.x == 0) {
        unsigned* bar = b.bar;
        __builtin_amdgcn_s_waitcnt(0);
        unsigned nloc = b.st[0], nx = b.st[1];
        if (nloc == 0u) { xcd_barrier_complete(bar, b.x, nloc, nx); b.st[0] = nloc; b.st[1] = nx; }
        const unsigned old = xb_add(&bar[XB_XSUB(b.x)], 1u);
        const unsigned gen = old / nloc;
        if (old + 1u == (gen + 1u) * nloc) {
            __builtin_amdgcn_fence(__ATOMIC_RELEASE, "agent");
            asm volatile("s_waitcnt vmcnt(0)" ::: "memory");
            const unsigned og = xb_add(&bar[XB_TOP], 1u);
            const unsigned tg = og / nx;
            if (og + 1u == (tg + 1u) * nx) xb_add(&bar[XB_TOPGEN], 1u);
            else XB_SPIN(xb_ld(&bar[XB_TOPGEN]) == tg, bar);
            __builtin_amdgcn_fence(__ATOMIC_ACQUIRE, "agent");
            asm volatile("buffer_inv sc0 sc1" ::: "memory");
            asm volatile("s_waitcnt vmcnt(0)" ::: "memory");
            xb_add(&bar[XB_XGEN(b.x)], 1u);
            asm volatile("s_waitcnt vmcnt(0)" ::: "memory");
        } else {
            XB_SPIN(xb_ld(&bar[XB_XGEN(b.x)]) == gen, bar);
            __builtin_amdgcn_fence(__ATOMIC_ACQUIRE, "agent");
            asm volatile("buffer_inv sc0 sc1" ::: "memory");
            asm volatile("s_waitcnt vmcnt(0)" ::: "memory");
        }
    }
    __syncthreads();
}

template <class FA, class FB, class FE>
__device__ __forceinline__ void ngemm(LAS float* sm, int M, int N, int K, int& tile_off, FA fa, FB fb, FE fe) {
    LAS float* As = sm;
    LAS float* Bs = sm + 16 * 65 + 15;
    Bs = sm + 1040;
    const int tid = threadIdx.x, ty = tid >> 4, tx = tid & 15, G = gridDim.x;
    const int tn = (N + 63) / 64, tm = (M + 63) / 64, tiles = tn * tm;
    int first = ((int)blockIdx.x - (tile_off % G) + G) % G;
    for (int t = first; t < tiles; t += G) {
        const int m0 = (t / tn) * 64, n0 = (t % tn) * 64;
        float acc[2][4];
#pragma unroll
        for (int i = 0; i < 2; ++i)
#pragma unroll
            for (int j = 0; j < 4; ++j) acc[i][j] = 0.f;
        for (int k0 = 0; k0 < K; k0 += 16) {
            __syncthreads();
#pragma unroll
            for (int j = 0; j < 2; ++j) {
                const int idx = tid + 512 * j;
                { const int m = idx >> 4, k = idx & 15; As[k * 65 + m] = (m0 + m < M) ? fa(m0 + m, k0 + k) : 0.f; }
                { const int k = idx >> 6, n = idx & 63; Bs[k * 64 + n] = (n0 + n < N) ? fb(k0 + k, n0 + n) : 0.f; }
            }
            __syncthreads();
#pragma unroll
            for (int k = 0; k < 16; ++k) {
                const float a0 = As[k * 65 + ty * 2], a1 = As[k * 65 + ty * 2 + 1];
                const f32x4 b = *(const LAS f32x4*)(Bs + k * 64 + tx * 4);
                acc[0][0] += a0 * b[0]; acc[0][1] += a0 * b[1]; acc[0][2] += a0 * b[2]; acc[0][3] += a0 * b[3];
                acc[1][0] += a1 * b[0]; acc[1][1] += a1 * b[1]; acc[1][2] += a1 * b[2]; acc[1][3] += a1 * b[3];
            }
        }
#pragma unroll
        for (int i = 0; i < 2; ++i)
#pragma unroll
            for (int j = 0; j < 4; ++j) { const int m = m0 + ty * 2 + i, n = n0 + tx * 4 + j; if (m < M && n < N) fe(m, n, acc[i][j]); }
    }
    tile_off += tiles;
}


#ifndef PG8_AUX
#define PG8_AUX 0
#endif
namespace pg8 {
#define PG8_LAS __attribute__((address_space(3)))
typedef unsigned short bf16_t;
typedef short bf16x8 __attribute__((ext_vector_type(8)));
typedef float f32x4 __attribute__((ext_vector_type(4)));
typedef unsigned u32x4 __attribute__((ext_vector_type(4)));
constexpr int BM = 256, BK = 64, HALF = 128, HTB = HALF * BK * 2  , STAGE_BYTES = 8 * HTB, NXCD = 8, WGM = 8;

__host__ __device__ __forceinline__ int lds_byte(int r, int c) { const int st = (r >> 4) * 2 + (c >> 5), rr = r & 15, cc = c & 31, ob = rr * 64 + cc * 2; return st * 1024 + (ob ^ (((ob >> 9) & 1) << 5)); }
__host__ __device__ __forceinline__ void stage_rc(int b, int& R, int& C) { const int st = b / 1024, sb = b % 1024, swz = sb ^ (((sb >> 9) & 1) << 5); R = (st >> 1) * 16 + swz / 64; C = (st & 1) * 32 + (swz % 64) / 2; }
__host__ __device__ __forceinline__ int perm32(int rho) { const int n = rho >> 4, i = rho & 15; return 8 * (i >> 2) + 4 * n + (i & 3); }

struct Unit { int pm, pn; };
struct Gemm { const bf16_t* A; const bf16_t* Bt; int M, N, K, lda, ldb; };

struct StaticOrder {
    int nM, nN, nwg, G, c;
    __host__ __device__ void init(int M, int N, int G_, int c_) { nM = M / BM; nN = N / BM; nwg = nM * nN; G = G_; c = c_; }
    __host__ __device__ bool next(int i, Unit& u) const {
        const long L = (long)i * G + c; if (L >= nwg) return false;
        int wgid = (int)L; { const int q = nwg / NXCD, r = nwg % NXCD, xcd = wgid % NXCD, off = wgid / NXCD; wgid = (xcd < r ? xcd * (q + 1) : r * (q + 1) + (xcd - r) * q) + off; }
        const int nig = WGM * nN, gid = wgid / nig, fm = gid * WGM, gsz = (nM - fm) < WGM ? (nM - fm) : WGM;
        u.pm = fm + ((wgid % nig) % gsz); u.pn = (wgid % nig) / gsz; return true;
    }
    __device__ __forceinline__ void a_ready(const Unit&) const {}
    __device__ __forceinline__ void done(const Unit&) const {}
};

__device__ __forceinline__ unsigned cvt_pk_bf16(float lo, float hi) { unsigned r; asm volatile("v_cvt_pk_bf16_f32 %0, %1, %2" : "=v"(r) : "v"(lo), "v"(hi)); return r; }

template <class Epi, class Sched, bool ALIGN_EPI = false, bool SP2 = false>
__device__ __forceinline__ void gemm_phase(PG8_LAS unsigned char* lds, const Gemm g, const Sched& S, const Epi& E) {
    const int tid = threadIdx.x, wid = __builtin_amdgcn_readfirstlane(tid >> 6), lane = tid & 63, wr = wid >> 2, wc = wid & 3, fr = lane & 15, fq = lane >> 4;
    const int K = g.K, nt = K / BK;
    unsigned voffA[2], voffB[2];
#pragma unroll
    for (int i = 0; i < 2; ++i) { int R, C; stage_rc(tid * 16 + i * 8192, R, C); const int Rb = Epi::PERM ? ((R & ~31) + perm32(R & 31)) : R;
        voffA[i] = (unsigned)(R * g.lda + C) * 2u; voffB[i] = (unsigned)(Rb * g.ldb + C) * 2u; }
    const size_t kstep = (size_t)(BK * 2);
    const size_t hstepA = (size_t)HALF * g.lda * 2, hstepB = (size_t)HALF * g.ldb * 2;
    const size_t tstepA = 2 * hstepA, tstepB = 2 * hstepB;
    const unsigned ldsw = (unsigned)wid * 1024u;
    const int aoff = lds_byte(wr * 64 + fr, fq * 8), boff = lds_byte(wc * 32 + fr, fq * 8);
#define PG8_SA(b, h) (((b) * 2 + (h)) * HTB)
#define PG8_SB(b, h) ((4 + (b) * 2 + (h)) * HTB)
#define PG8_STAGE(bufoff, gbase, voff) do { _Pragma("unroll") for (int _i = 0; _i < 2; ++_i) \
        __builtin_amdgcn_global_load_lds((const unsigned*)((const char*)(gbase) + (voff)[_i]), (PG8_LAS unsigned*)(lds + (bufoff) + ldsw + _i * 8192), 16, 0, PG8_AUX); } while (0)
#define PG8_LDA(dst, b, h) do { _Pragma("unroll") for (int m = 0; m < 4; ++m) _Pragma("unroll") for (int k = 0; k < 2; ++k) dst[m][k] = *(const PG8_LAS bf16x8*)(lds + PG8_SA(b, h) + aoff + m * 2048 + k * 1024); } while (0)
#define PG8_LDB(dst, b, h) do { _Pragma("unroll") for (int n = 0; n < 2; ++n) _Pragma("unroll") for (int k = 0; k < 2; ++k) dst[n][k] = *(const PG8_LAS bf16x8*)(lds + PG8_SB(b, h) + boff + n * 2048 + k * 1024); } while (0)
#define PG8_MMA(ai, bj, At, Bt) do { __builtin_amdgcn_s_setprio(1); _Pragma("unroll") for (int m = 0; m < 4; ++m) _Pragma("unroll") for (int n = 0; n < 2; ++n) _Pragma("unroll") for (int k = 0; k < 2; ++k) \
        acc[ai][bj][m][n] = __builtin_amdgcn_mfma_f32_16x16x32_bf16(Bt[n][k], At[m][k], acc[ai][bj][m][n], 0, 0, 0); __builtin_amdgcn_s_setprio(0); } while (0)
#define PG8_WAIT_V(n) asm volatile("s_waitcnt vmcnt(" #n ")" ::: "memory")
#define PG8_WAIT_L(n) asm volatile("s_waitcnt lgkmcnt(" #n ")" ::: "memory")
#define PG8_BAR __builtin_amdgcn_s_barrier()
#define PG8_SCHED __builtin_amdgcn_sched_barrier(0)
    Unit cur, nxt; int ui = 0;
    if (!S.next(0, cur)) return;
    f32x4 acc[2][2][4][2];
#pragma unroll
    for (int a = 0; a < 2; ++a)
#pragma unroll
        for (int b = 0; b < 2; ++b)
#pragma unroll
            for (int m = 0; m < 4; ++m)
#pragma unroll
                for (int n = 0; n < 2; ++n) acc[a][b][m][n] = (f32x4){0.f, 0.f, 0.f, 0.f};
    bf16x8 At[4][2], B0[2][2], B1[2][2];
    const char* cA = (const char*)g.A + (size_t)cur.pm * tstepA; const char* cB = (const char*)g.Bt + (size_t)cur.pn * tstepB;
    S.a_ready(cur);
    if constexpr (SP2) {
        PG8_STAGE(PG8_SB(0, 0), cB, voffB); PG8_STAGE(PG8_SB(0, 1), cB + hstepB, voffB); PG8_STAGE(PG8_SA(0, 0), cA, voffA); PG8_STAGE(PG8_SA(0, 1), cA + hstepA, voffA);
        if (wr == 1) PG8_BAR;
        PG8_WAIT_V(2); PG8_BAR;
        PG8_STAGE(PG8_SB(1, 0), cB + kstep, voffB); PG8_STAGE(PG8_SA(1, 0), cA + kstep, voffA); PG8_STAGE(PG8_SB(1, 1), cB + hstepB + kstep, voffB);
        PG8_WAIT_V(6); PG8_BAR;
    } else {
        PG8_STAGE(PG8_SB(0, 0), cB, voffB); PG8_STAGE(PG8_SA(0, 0), cA, voffA); PG8_STAGE(PG8_SB(0, 1), cB + hstepB, voffB); PG8_STAGE(PG8_SA(0, 1), cA + hstepA, voffA);
        if (wr == 1) PG8_BAR;
        PG8_WAIT_V(4); PG8_BAR;
        PG8_STAGE(PG8_SB(1, 0), cB + kstep, voffB); PG8_STAGE(PG8_SA(1, 0), cA + kstep, voffA); PG8_STAGE(PG8_SB(1, 1), cB + hstepB + kstep, voffB);
        PG8_WAIT_V(6); PG8_BAR;
    }
    for (;;) {
        const bool has_next = S.next(ui + 1, nxt);
        const char* nA = has_next ? (const char*)g.A + (size_t)nxt.pm * tstepA : cA; const char* nB = has_next ? (const char*)g.Bt + (size_t)nxt.pn * tstepB : cB;
#pragma unroll 1
        for (int t = 0; t < nt; t += 2) {
            const bool last = (t == nt - 2);
            const char* a1 = cA + (size_t)(t + 1) * kstep;
            const char* a2 = last ? nA : cA + (size_t)(t + 2) * kstep; const char* b2 = last ? nB : cB + (size_t)(t + 2) * kstep;
            const char* a3 = a2 + kstep; const char* b3 = b2 + kstep;
            if (last && has_next) S.a_ready(nxt);
            if constexpr (SP2) {
            PG8_LDB(B0, 0, 0); PG8_LDB(B1, 0, 1); PG8_SCHED; PG8_LDA(At, 0, 0); PG8_STAGE(PG8_SA(1, 1), a1 + hstepA, voffA);
            PG8_WAIT_V(8); PG8_WAIT_L(0); PG8_BAR; PG8_MMA(0, 0, At, B0); PG8_MMA(0, 1, At, B1); PG8_BAR; PG8_SCHED;
            PG8_LDA(At, 0, 1); PG8_STAGE(PG8_SB(0, 0), b2, voffB); PG8_STAGE(PG8_SB(0, 1), b2 + hstepB, voffB); PG8_STAGE(PG8_SA(0, 0), a2, voffA);
            PG8_WAIT_V(8); PG8_WAIT_L(0); PG8_BAR; PG8_MMA(1, 0, At, B0); PG8_MMA(1, 1, At, B1); PG8_BAR; PG8_SCHED;
            PG8_LDB(B0, 1, 0); PG8_LDB(B1, 1, 1); PG8_SCHED; PG8_LDA(At, 1, 0); PG8_STAGE(PG8_SA(0, 1), a2 + hstepA, voffA);
            PG8_WAIT_V(8); PG8_WAIT_L(0); PG8_BAR; PG8_MMA(0, 0, At, B0); PG8_MMA(0, 1, At, B1); PG8_BAR; PG8_SCHED;
            PG8_LDA(At, 1, 1); PG8_STAGE(PG8_SB(1, 0), b3, voffB); PG8_STAGE(PG8_SB(1, 1), b3 + hstepB, voffB); PG8_STAGE(PG8_SA(1, 0), a3, voffA);
            PG8_WAIT_V(8); PG8_WAIT_L(0); PG8_BAR; PG8_MMA(1, 0, At, B0); PG8_MMA(1, 1, At, B1); PG8_BAR; PG8_SCHED;
            } else {
            PG8_LDB(B0, 0, 0); PG8_SCHED; PG8_LDA(At, 0, 0); PG8_STAGE(PG8_SA(1, 1), a1 + hstepA, voffA);
            PG8_WAIT_L(8); PG8_BAR; PG8_WAIT_L(0); PG8_MMA(0, 0, At, B0); PG8_BAR; PG8_SCHED;
            PG8_LDB(B1, 0, 1); PG8_STAGE(PG8_SB(0, 0), b2, voffB);
            PG8_BAR; PG8_WAIT_L(0); PG8_MMA(0, 1, At, B1); PG8_BAR;
            PG8_LDA(At, 0, 1); PG8_STAGE(PG8_SA(0, 0), a2, voffA);
            PG8_BAR; PG8_WAIT_L(0); PG8_MMA(1, 0, At, B0); PG8_BAR; PG8_SCHED;
            PG8_STAGE(PG8_SB(0, 1), b2 + hstepB, voffB);
            PG8_WAIT_V(6); PG8_BAR; PG8_MMA(1, 1, At, B1); PG8_BAR;
            PG8_LDB(B0, 1, 0); PG8_SCHED; PG8_LDA(At, 1, 0); PG8_STAGE(PG8_SA(0, 1), a2 + hstepA, voffA);
            PG8_WAIT_L(8); PG8_BAR; PG8_WAIT_L(0); PG8_MMA(0, 0, At, B0); PG8_BAR; PG8_SCHED;
            PG8_LDB(B1, 1, 1); PG8_STAGE(PG8_SB(1, 0), b3, voffB);
            PG8_BAR; PG8_WAIT_L(0); PG8_MMA(0, 1, At, B1); PG8_BAR;
            PG8_LDA(At, 1, 1); PG8_STAGE(PG8_SA(1, 0), a3, voffA);
            PG8_BAR; PG8_WAIT_L(0); PG8_MMA(1, 0, At, B0); PG8_BAR; PG8_SCHED;
            PG8_STAGE(PG8_SB(1, 1), b3 + hstepB, voffB);
            PG8_WAIT_V(6); PG8_BAR; PG8_MMA(1, 1, At, B1); PG8_BAR;
            }
        }
        if constexpr (ALIGN_EPI) { if (wr == 0) PG8_BAR; }
        if constexpr (!Epi::AFTER_DRAIN) { E(acc, cur, wr, wc, fr, fq); S.done(cur); }
        if (!has_next) break;
#pragma unroll
        for (int a = 0; a < 2; ++a)
#pragma unroll
            for (int b = 0; b < 2; ++b)
#pragma unroll
                for (int m = 0; m < 4; ++m)
#pragma unroll
                    for (int n = 0; n < 2; ++n) acc[a][b][m][n] = (f32x4){0.f, 0.f, 0.f, 0.f};
        cur = nxt; cA = nA; cB = nB; ++ui;
        if constexpr (ALIGN_EPI) { if (wr == 1) PG8_BAR; }
    }
    PG8_WAIT_V(0);
    if constexpr (!ALIGN_EPI) { if (wr == 0) PG8_BAR; }
    PG8_BAR;
    if constexpr (Epi::AFTER_DRAIN) { E.fused(acc, cur, wr, wc, fr, fq, lds, wid, lane); S.done(cur); }
#undef PG8_SA
#undef PG8_SB
#undef PG8_STAGE
#undef PG8_LDA
#undef PG8_LDB
#undef PG8_MMA
#undef PG8_WAIT_V
#undef PG8_WAIT_L
#undef PG8_BAR
#undef PG8_SCHED
}

template <class Epi, class Sched>
__device__ __forceinline__ void gemm_phase_g(PG8_LAS unsigned char* lds, const Gemm g, const Sched& S, const Epi& E) {
    const int tid = threadIdx.x, wid = __builtin_amdgcn_readfirstlane(tid >> 6), lane = tid & 63, wr = wid >> 2, wc = wid & 3, fr = lane & 15, fq = lane >> 4;
    const int K = g.K, nt = K / BK;
    unsigned voffB[2]; int RA[2], CA[2];
#pragma unroll
    for (int i = 0; i < 2; ++i) { int R, C; stage_rc(tid * 16 + i * 8192, R, C); const int Rb = Epi::PERM ? ((R & ~31) + perm32(R & 31)) : R;
        RA[i] = R; CA[i] = C * 2; voffB[i] = (unsigned)(Rb * g.ldb + C) * 2u; }
    const size_t kstep = (size_t)(BK * 2);
    const size_t hstepB = (size_t)HALF * g.ldb * 2, tstepB = 2 * hstepB;
    const unsigned ldsw = (unsigned)wid * 1024u;
    const int aoff = lds_byte(wr * 64 + fr, fq * 8), boff = lds_byte(wc * 32 + fr, fq * 8);
#define PG8_SA(b, h) (((b) * 2 + (h)) * HTB)
#define PG8_SB(b, h) ((4 + (b) * 2 + (h)) * HTB)
#define PG8_STAGE(bufoff, gbase, voff) do { _Pragma("unroll") for (int _i = 0; _i < 2; ++_i) \
        __builtin_amdgcn_global_load_lds((const unsigned*)((const char*)(gbase) + (voff)[_i]), (PG8_LAS unsigned*)(lds + (bufoff) + ldsw + _i * 8192), 16, 0, PG8_AUX); } while (0)
#define PG8_LDA(dst, b, h) do { _Pragma("unroll") for (int m = 0; m < 4; ++m) _Pragma("unroll") for (int k = 0; k < 2; ++k) dst[m][k] = *(const PG8_LAS bf16x8*)(lds + PG8_SA(b, h) + aoff + m * 2048 + k * 1024); } while (0)
#define PG8_LDB(dst, b, h) do { _Pragma("unroll") for (int n = 0; n < 2; ++n) _Pragma("unroll") for (int k = 0; k < 2; ++k) dst[n][k] = *(const PG8_LAS bf16x8*)(lds + PG8_SB(b, h) + boff + n * 2048 + k * 1024); } while (0)
#define PG8_MMA(ai, bj, At, Bt) do { __builtin_amdgcn_s_setprio(1); _Pragma("unroll") for (int m = 0; m < 4; ++m) _Pragma("unroll") for (int n = 0; n < 2; ++n) _Pragma("unroll") for (int k = 0; k < 2; ++k) \
        acc[ai][bj][m][n] = __builtin_amdgcn_mfma_f32_16x16x32_bf16(Bt[n][k], At[m][k], acc[ai][bj][m][n], 0, 0, 0); __builtin_amdgcn_s_setprio(0); } while (0)
#define PG8_WAIT_V(n) asm volatile("s_waitcnt vmcnt(" #n ")" ::: "memory")
#define PG8_WAIT_L(n) asm volatile("s_waitcnt lgkmcnt(0)" ::: "memory")
#define PG8_BAR __builtin_amdgcn_s_barrier()
#define PG8_SCHED __builtin_amdgcn_sched_barrier(0)
#define PG8_ROWOFFS(u_, v0_, v1_) do { _Pragma("unroll") for (int _i = 0; _i < 2; ++_i) { \
        v0_[_i] = (unsigned)S.a_tok(u_, RA[_i]) * (unsigned)(g.lda * 2) + (unsigned)CA[_i]; v1_[_i] = (unsigned)S.a_tok(u_, RA[_i] + HALF) * (unsigned)(g.lda * 2) + (unsigned)CA[_i]; } } while (0)
    Unit cur, nxt; int ui = 0;
    if (!S.next(0, cur)) return;
    f32x4 acc[2][2][4][2];
#pragma unroll
    for (int a = 0; a < 2; ++a)
#pragma unroll
        for (int b = 0; b < 2; ++b)
#pragma unroll
            for (int m = 0; m < 4; ++m)
#pragma unroll
                for (int n = 0; n < 2; ++n) acc[a][b][m][n] = (f32x4){0.f, 0.f, 0.f, 0.f};
    bf16x8 At[4][2], B0[2][2], B1[2][2];
    const char* const gA = (const char*)g.A; const char* cB = (const char*)g.Bt + (size_t)cur.pn * tstepB;
    unsigned cv0[2], cv1[2], nv0[2], nv1[2];
    PG8_ROWOFFS(cur, cv0, cv1);
    asm volatile("s_waitcnt vmcnt(0)" ::: "memory");
    PG8_STAGE(PG8_SB(0, 0), cB, voffB); PG8_STAGE(PG8_SB(0, 1), cB + hstepB, voffB); PG8_STAGE(PG8_SA(0, 0), gA, cv0); PG8_STAGE(PG8_SA(0, 1), gA, cv1);
    if (wr == 1) PG8_BAR;
    PG8_WAIT_V(2); PG8_BAR;
    PG8_STAGE(PG8_SB(1, 0), cB + kstep, voffB); PG8_STAGE(PG8_SA(1, 0), gA + kstep, cv0); PG8_STAGE(PG8_SB(1, 1), cB + hstepB + kstep, voffB);
    PG8_WAIT_V(6); PG8_BAR;
    for (;;) {
        const bool has_next = S.next(ui + 1, nxt);
        const char* nB = has_next ? (const char*)g.Bt + (size_t)nxt.pn * tstepB : cB;
        if (has_next) PG8_ROWOFFS(nxt, nv0, nv1); else { nv0[0] = cv0[0]; nv0[1] = cv0[1]; nv1[0] = cv1[0]; nv1[1] = cv1[1]; }
        asm volatile("s_waitcnt vmcnt(0)" ::: "memory");
#pragma unroll 1
        for (int t = 0; t < nt; t += 2) {
            const bool last = (t == nt - 2);
            const char* a1 = gA + (size_t)(t + 1) * kstep;
            const char* a2 = last ? gA : gA + (size_t)(t + 2) * kstep; const char* b2 = last ? nB : cB + (size_t)(t + 2) * kstep;
            const char* a3 = a2 + kstep; const char* b3 = b2 + kstep;
            unsigned s0[2], s1[2];
            s0[0] = last ? nv0[0] : cv0[0]; s0[1] = last ? nv0[1] : cv0[1]; s1[0] = last ? nv1[0] : cv1[0]; s1[1] = last ? nv1[1] : cv1[1];
            PG8_LDB(B0, 0, 0); PG8_LDB(B1, 0, 1); PG8_SCHED; PG8_LDA(At, 0, 0); PG8_STAGE(PG8_SA(1, 1), a1, cv1);
            PG8_WAIT_V(8); PG8_WAIT_L(0); PG8_BAR; PG8_MMA(0, 0, At, B0); PG8_MMA(0, 1, At, B1); PG8_BAR; PG8_SCHED;
            PG8_LDA(At, 0, 1); PG8_STAGE(PG8_SB(0, 0), b2, voffB); PG8_STAGE(PG8_SB(0, 1), b2 + hstepB, voffB); PG8_STAGE(PG8_SA(0, 0), a2, s0);
            PG8_WAIT_V(8); PG8_WAIT_L(0); PG8_BAR; PG8_MMA(1, 0, At, B0); PG8_MMA(1, 1, At, B1); PG8_BAR; PG8_SCHED;
            PG8_LDB(B0, 1, 0); PG8_LDB(B1, 1, 1); PG8_SCHED; PG8_LDA(At, 1, 0); PG8_STAGE(PG8_SA(0, 1), a2, s1);
            PG8_WAIT_V(8); PG8_WAIT_L(0); PG8_BAR; PG8_MMA(0, 0, At, B0); PG8_MMA(0, 1, At, B1); PG8_BAR; PG8_SCHED;
            PG8_LDA(At, 1, 1); PG8_STAGE(PG8_SB(1, 0), b3, voffB); PG8_STAGE(PG8_SB(1, 1), b3 + hstepB, voffB); PG8_STAGE(PG8_SA(1, 0), a3, s0);
            PG8_WAIT_V(8); PG8_WAIT_L(0); PG8_BAR; PG8_MMA(1, 0, At, B0); PG8_MMA(1, 1, At, B1); PG8_BAR; PG8_SCHED;
        }
        if (wr == 0) PG8_BAR;
        E(acc, cur, wr, wc, fr, fq);
        if (!has_next) break;
#pragma unroll
        for (int a = 0; a < 2; ++a)
#pragma unroll
            for (int b = 0; b < 2; ++b)
#pragma unroll
                for (int m = 0; m < 4; ++m)
#pragma unroll
                    for (int n = 0; n < 2; ++n) acc[a][b][m][n] = (f32x4){0.f, 0.f, 0.f, 0.f};
        cur = nxt; cB = nB; ++ui; cv0[0] = nv0[0]; cv0[1] = nv0[1]; cv1[0] = nv1[0]; cv1[1] = nv1[1];
        if (wr == 1) PG8_BAR;
    }
    PG8_WAIT_V(0);
    PG8_BAR;
#undef PG8_ROWOFFS
#undef PG8_SA
#undef PG8_SB
#undef PG8_STAGE
#undef PG8_LDA
#undef PG8_LDB
#undef PG8_MMA
#undef PG8_WAIT_V
#undef PG8_WAIT_L
#undef PG8_BAR
#undef PG8_SCHED
}
}

#define PG8_SP2 true
#define PG8_ALIGN true
namespace pg8 {
__device__ __forceinline__ void store8(bf16_t* p, f32x4 v0, f32x4 v1) { u32x4 w; w.x = cvt_pk_bf16(v0[0], v0[1]); w.y = cvt_pk_bf16(v0[2], v0[3]); w.z = cvt_pk_bf16(v1[0], v1[1]); w.w = cvt_pk_bf16(v1[2], v1[3]); *(u32x4*)p = w; }
__device__ __forceinline__ float sigm(float x) { return __builtin_amdgcn_rcpf(1.f + __builtin_amdgcn_exp2f(-1.4426950408889634f * x)); }
typedef unsigned u32x2 __attribute__((ext_vector_type(2)));
__device__ __forceinline__ void rope_store(bf16_t* p1, bf16_t* p2, f32x4 v0, f32x4 v1, f32x4 c, f32x4 s, float sc) {
    const float a0 = v0[0] * sc, b0 = v0[1] * sc, a1 = v0[2] * sc, b1 = v0[3] * sc, a2 = v1[0] * sc, b2 = v1[1] * sc, a3 = v1[2] * sc, b3 = v1[3] * sc;
    u32x2 o1, o2;
    o1.x = cvt_pk_bf16(a0 * c[0] - b0 * s[0], a1 * c[1] - b1 * s[1]); o1.y = cvt_pk_bf16(a2 * c[2] - b2 * s[2], a3 * c[3] - b3 * s[3]);
    o2.x = cvt_pk_bf16(b0 * c[0] + a0 * s[0], b1 * c[1] + a1 * s[1]); o2.y = cvt_pk_bf16(b2 * c[2] + a2 * s[2], b3 * c[3] + a3 * s[3]);
    *(u32x2*)p1 = o1; *(u32x2*)p2 = o2;
}
struct EpiStore {
    static constexpr bool PERM = true, AFTER_DRAIN = false;
    bf16_t* O; int ldc;
    __device__ __forceinline__ void operator()(const f32x4 (&acc)[2][2][4][2], const Unit& u, int wr, int wc, int fr, int fq) const {
        const int row0 = u.pm * BM + wr * 64 + fr, col0 = u.pn * BM + wc * 32 + 8 * fq;
#pragma unroll
        for (int ai = 0; ai < 2; ++ai)
#pragma unroll
            for (int m = 0; m < 4; ++m)
#pragma unroll
                for (int bj = 0; bj < 2; ++bj) store8(O + (size_t)(row0 + ai * HALF + m * 16) * ldc + col0 + bj * HALF, acc[ai][bj][m][0], acc[ai][bj][m][1]);
    }
};
struct EpiQ {
    static constexpr bool PERM = true, AFTER_DRAIN = false;
    bf16_t *qn, *qr; const float *rsq, *ropeC, *ropeS;
    __device__ __forceinline__ void operator()(const f32x4 (&acc)[2][2][4][2], const Unit& u, int wr, int wc, int fr, int fq) const {
        const int row0 = u.pm * BM + wr * 64 + fr;
        float rsv[2][4];
#pragma unroll
        for (int ai = 0; ai < 2; ++ai)
#pragma unroll
            for (int m = 0; m < 4; ++m) rsv[ai][m] = rsq[row0 + ai * HALF + m * 16] * QSCALE_MLA;
        if (u.pn < 4) {
            bf16_t* base = qn + u.pn * BM + wc * 32 + 8 * fq;
#pragma unroll
            for (int ai = 0; ai < 2; ++ai)
#pragma unroll
                for (int m = 0; m < 4; ++m) { const int row = row0 + ai * HALF + m * 16; const float rs = rsv[ai][m];
#pragma unroll
                    for (int bj = 0; bj < 2; ++bj) store8(base + (size_t)row * 1024 + bj * HALF, acc[ai][bj][m][0] * rs, acc[ai][bj][m][1] * rs); }
        } else {
#pragma unroll
            for (int bj = 0; bj < 2; ++bj) {
                const int cb = (u.pn - 4) * BM + bj * HALF + wc * 32 + 8 * fq, hd = cb >> 6, i0 = (cb & 63) >> 1;
                bf16_t* qb = qr + hd * 64 + i0;
#pragma unroll
                for (int ai = 0; ai < 2; ++ai)
#pragma unroll
                    for (int m = 0; m < 4; ++m) { const int row = row0 + ai * HALF + m * 16;
                        const f32x4 cc = *(const f32x4*)(ropeC + (size_t)row * 32 + i0), sn = *(const f32x4*)(ropeS + (size_t)row * 32 + i0);
                        rope_store(qb + (size_t)row * 512, qb + (size_t)row * 512 + 32, acc[ai][bj][m][0], acc[ai][bj][m][1], cc, sn, rsv[ai][m]);
                        asm volatile("" ::: "memory"); }
            }
        }
    }
};
struct EpiKV {
    static constexpr bool PERM = true, AFTER_DRAIN = false;
    bf16_t *kn, *vv; const float* rskv;
    __device__ __forceinline__ void operator()(const f32x4 (&acc)[2][2][4][2], const Unit& u, int wr, int wc, int fr, int fq) const {
        const int row0 = u.pm * BM + wr * 64 + fr; bf16_t* base = (u.pn < 4 ? kn + u.pn * BM : vv + (u.pn - 4) * BM) + wc * 32 + 8 * fq;
#pragma unroll
        for (int ai = 0; ai < 2; ++ai)
#pragma unroll
            for (int m = 0; m < 4; ++m) { const int row = row0 + ai * HALF + m * 16; const float rs = rskv[row];
#pragma unroll
                for (int bj = 0; bj < 2; ++bj) store8(base + (size_t)row * 1024 + bj * HALF, acc[ai][bj][m][0] * rs, acc[ai][bj][m][1] * rs); }
    }
};
template <int MODE> struct EpiGate {
    static constexpr bool PERM = true, AFTER_DRAIN = false;
    const bf16_t* gl; const float* gate_b; int goff; float* m32; bf16_t* merged;
    __device__ __forceinline__ void operator()(const f32x4 (&acc)[2][2][4][2], const Unit& u, int wr, int wc, int fr, int fq) const {
        const int row0 = u.pm * BM + wr * 64 + fr, col0 = u.pn * BM + wc * 32 + 8 * fq;
#pragma unroll
        for (int bj = 0; bj < 2; ++bj) { const int col = col0 + bj * HALF;
            const f32x4 b0 = *(const f32x4*)(gate_b + goff + col), b1 = *(const f32x4*)(gate_b + goff + col + 4);
#pragma unroll
            for (int ai = 0; ai < 2; ++ai)
#pragma unroll
                for (int m = 0; m < 4; ++m) { const size_t row = (size_t)(row0 + ai * HALF + m * 16);
                    const u32x4 gw = *(const u32x4*)(gl + row * 3072 + goff + col);
                    f32x4 g0, g1; g0[0] = __uint_as_float(gw.x << 16); g0[1] = __uint_as_float(gw.x & 0xffff0000u); g0[2] = __uint_as_float(gw.y << 16); g0[3] = __uint_as_float(gw.y & 0xffff0000u);
                    g1[0] = __uint_as_float(gw.z << 16); g1[1] = __uint_as_float(gw.z & 0xffff0000u); g1[2] = __uint_as_float(gw.w << 16); g1[3] = __uint_as_float(gw.w & 0xffff0000u);
                    g0 += b0; g1 += b1;
#pragma unroll
                    for (int j = 0; j < 4; ++j) { g0[j] = sigm(g0[j]); g1[j] = sigm(g1[j]); }
                    f32x4 v0 = acc[ai][bj][m][0] * g0, v1 = acc[ai][bj][m][1] * g1;
                    float* mp = m32 + row * 1024 + col;
                    if (MODE >= 1) { v0 += *(const f32x4*)mp; v1 += *(const f32x4*)(mp + 4); }
                    if (MODE <= 1) { *(f32x4*)mp = v0; *(f32x4*)(mp + 4) = v1; }
                    else store8(merged + row * 1024 + col, v0, v1); } }
    }
};
struct EpiRes {
    static constexpr bool PERM = false, AFTER_DRAIN = false;
    const float* x; float* x1;
    __device__ __forceinline__ void operator()(const f32x4 (&acc)[2][2][4][2], const Unit& u, int wr, int wc, int fr, int fq) const {
        const int row0 = u.pm * BM + wr * 64 + fr, col0 = u.pn * BM + wc * 32 + 4 * fq;
#pragma unroll
        for (int ai = 0; ai < 2; ++ai)
#pragma unroll
            for (int m = 0; m < 4; ++m) { const size_t off = (size_t)(row0 + ai * HALF + m * 16) * 1024 + col0;
#pragma unroll
                for (int bj = 0; bj < 2; ++bj)
#pragma unroll
                    for (int n = 0; n < 2; ++n) *(f32x4*)(x1 + off + bj * HALF + n * 16) = *(const f32x4*)(x + off + bj * HALF + n * 16) + acc[ai][bj][m][n]; }
    }
};

struct MoeOrder {
    const PG8_LAS int* tab; int nrb, ntn, G, c; const int* list; const unsigned* cnt;
    __device__ __forceinline__ bool next(int i, Unit& u) const {
        const int L = i * G + c; if (L >= nrb * ntn) return false;
        const int rb = L / ntn, ct = L - rb * ntn, tv = __builtin_amdgcn_readfirstlane(tab[rb]);
        u.pm = rb; u.pn = (tv & 255) * ntn + ct; return true; }
    __device__ __forceinline__ int a_tok(const Unit& u, int row) const {
        const int tv = __builtin_amdgcn_readfirstlane(tab[u.pm]), e = tv & 255, r = (tv >> 8) * 256 + row;
        return r < (int)cnt[e] ? (list[e * T + r] >> 1) : 0; }
    __device__ __forceinline__ void a_ready(const Unit&) const {}
    __device__ __forceinline__ void done(const Unit&) const {}
};
struct EpiMoeUp {
    static constexpr bool PERM = true, AFTER_DRAIN = false;
    bf16_t* hmid;
    __device__ __forceinline__ void operator()(const f32x4 (&acc)[2][2][4][2], const Unit& u, int wr, int wc, int fr, int fq) const {
        const int row0 = u.pm * BM + wr * 64 + fr, hc0 = ((u.pn & 1) * BM + wc * 32 + 8 * fq) >> 1;
#pragma unroll
        for (int ai = 0; ai < 2; ++ai)
#pragma unroll
            for (int m = 0; m < 4; ++m)
#pragma unroll
                for (int bj = 0; bj < 2; ++bj) { const f32x4 gt = acc[ai][bj][m][0], up = acc[ai][bj][m][1]; u32x2 o;
                    o.x = cvt_pk_bf16(gt[0] * sigm(gt[0]) * up[0], gt[1] * sigm(gt[1]) * up[1]); o.y = cvt_pk_bf16(gt[2] * sigm(gt[2]) * up[2], gt[3] * sigm(gt[3]) * up[3]);
                    *(u32x2*)(hmid + (size_t)(row0 + ai * HALF + m * 16) * 256 + hc0 + bj * 64) = o; }
    }
};
struct EpiMoeDown {
    static constexpr bool PERM = true, AFTER_DRAIN = false;
    bf16_t* yslot; const int* list; const unsigned* cnt; const float* aw; const PG8_LAS int* tab;
    __device__ __forceinline__ void operator()(const f32x4 (&acc)[2][2][4][2], const Unit& u, int wr, int wc, int fr, int fq) const {
        const int tv = __builtin_amdgcn_readfirstlane(tab[u.pm]), e = tv & 255, base = (tv >> 8) * 256, ce = (int)cnt[e];
        const int col0 = (u.pn & 3) * BM + wc * 32 + 8 * fq; const int* le = list + e * T + base;
#pragma unroll
        for (int ai = 0; ai < 2; ++ai)
#pragma unroll
            for (int m = 0; m < 4; ++m) { const int r = wr * 64 + ai * HALF + m * 16 + fr;
                if (base + r < ce) { const int a = le[r]; const float w = aw[a];
#pragma unroll
                    for (int bj = 0; bj < 2; ++bj) store8(yslot + (size_t)a * 1024 + col0 + bj * HALF, acc[ai][bj][m][0] * w, acc[ai][bj][m][1] * w); } }
    }
};
}


namespace fa {
typedef short bf16x8 __attribute__((ext_vector_type(8)));
typedef short s16x4 __attribute__((ext_vector_type(4)));
typedef float f32x16 __attribute__((ext_vector_type(16)));
typedef unsigned u32x4 __attribute__((ext_vector_type(4)));
__device__ __forceinline__ int crow(int r, int hi) { return (r & 3) + 8 * (r >> 2) + 4 * hi; }
__device__ __forceinline__ unsigned cvtpk(float lo, float hi) { unsigned r; asm volatile("v_cvt_pk_bf16_f32 %0, %1, %2" : "=v"(r) : "v"(lo), "v"(hi)); return r; }
__device__ __forceinline__ int v_rd_base(int lane) { return ((lane & 3) << 3) | (((lane >> 2) & 3) << 6) | (((lane >> 4) & 1) << 5) | (((lane >> 5) & 1) << 8); }
constexpr int v_rd_off(int d0, int ks, int half) { return d0 * 512 + ks * 4096 + half * 2048; }
template <int OFF> __device__ __forceinline__ s16x4 tr_read(int vb) { s16x4 r; asm volatile("ds_read_b64_tr_b16 %0, %1 offset:%2" : "=&v"(r) : "v"(vb), "i"(OFF) : "memory"); return r; }
template <int D0> __device__ __forceinline__ void pv_one(f32x16& od, int vb, bf16x8 pa0, bf16x8 pa1, bf16x8 pa2, bf16x8 pa3) {
    const s16x4 l0 = tr_read<v_rd_off(D0, 0, 0)>(vb), h0 = tr_read<v_rd_off(D0, 0, 1)>(vb), l1 = tr_read<v_rd_off(D0, 1, 0)>(vb), h1 = tr_read<v_rd_off(D0, 1, 1)>(vb);
    const s16x4 l2 = tr_read<v_rd_off(D0, 2, 0)>(vb), h2 = tr_read<v_rd_off(D0, 2, 1)>(vb), l3 = tr_read<v_rd_off(D0, 3, 0)>(vb), h3 = tr_read<v_rd_off(D0, 3, 1)>(vb);
    asm volatile("s_waitcnt lgkmcnt(0)" ::: "memory"); __builtin_amdgcn_sched_barrier(0);
#define FA_PK(L, H) (bf16x8){L[0], L[1], L[2], L[3], H[0], H[1], H[2], H[3]}
    od = __builtin_amdgcn_mfma_f32_32x32x16_bf16(pa0, FA_PK(l0, h0), od, 0, 0, 0);
    od = __builtin_amdgcn_mfma_f32_32x32x16_bf16(pa1, FA_PK(l1, h1), od, 0, 0, 0);
    od = __builtin_amdgcn_mfma_f32_32x32x16_bf16(pa2, FA_PK(l2, h2), od, 0, 0, 0);
    od = __builtin_amdgcn_mfma_f32_32x32x16_bf16(pa3, FA_PK(l3, h3), od, 0, 0, 0);
#undef FA_PK
}
template <int NQ, bool CAUSAL>
__device__ __forceinline__ void attn_block(const bf16* Qa, int ldqa, const bf16* Qb, int ldqb, const bf16* Ka, int ldka, const bf16* Kb, int ldkb,
                                           const bf16* V, int ldv, bf16* O, int ldo, int P0, int nkeys, LAS unsigned char* lds) {
    constexpr int KROWB = NQ * 32, SHM_K = 64 * KROWB, SHM_V = 64 * 256, NKI = SHM_K / 8192, NVI = 2;
    const int tid = threadIdx.x, wid = __builtin_amdgcn_readfirstlane(tid >> 6), lane = tid & 63, r32 = lane & 31, hi = lane >> 5;
    LAS unsigned char* K_lds = lds; LAS unsigned char* V_lds = lds + 2 * SHM_K;
    LAS float* wsf = (LAS float*)(lds + 2 * SHM_K + 2 * SHM_V) + wid * 64; LAS float* li_l = wsf; LAS float* al_l = wsf + 32;
    bf16x8 qr[NQ];
    { const bf16* qa = Qa + (size_t)(wid * 32 + r32) * ldqa + hi * 8;
#pragma unroll
      for (int d0 = 0; d0 < 8; ++d0) qr[d0] = *(const bf16x8*)(qa + d0 * 16);
      if constexpr (NQ == 12) { const bf16* qb = Qb + (size_t)(wid * 32 + r32) * ldqb + hi * 8;
#pragma unroll
          for (int d0 = 0; d0 < 4; ++d0) qr[8 + d0] = *(const bf16x8*)(qb + d0 * 16); } }
    int kso[NKI]; bool ksb[NKI]; int vso[NVI];
#pragma unroll
    for (int i = 0; i < NKI; ++i) { const int pch = i * 512 + tid, row = pch / (NQ * 2), cc = pch % (NQ * 2), sc = (cc & ~7) | ((cc & 7) ^ (row & 7));
        ksb[i] = (NQ == 12) && sc >= 16; kso[i] = ksb[i] ? row * ldkb + (sc - 16) * 8 : row * ldka + sc * 8; }
#pragma unroll
    for (int i = 0; i < NVI; ++i) { const int byte = (i * 512 + tid) * 16, sub = byte >> 9, within = byte & 511, kk = (sub >> 2) * 8 + (within >> 6), c = (sub & 3) * 32 + ((within & 63) >> 1);
        const int k = (kk & ~0xC) | ((kk & 4) << 1) | ((kk & 8) >> 1); vso[i] = k * ldv + c; }
    const int NT = CAUSAL ? (P0 + 256) / 64 : nkeys / 64;
    const unsigned ldsw = (unsigned)wid * 1024u;
#define FA_ISSUE(t_, buf_) do { const size_t kb_ = (size_t)(t_) * 64; \
        _Pragma("unroll") for (int i_ = 0; i_ < NKI; ++i_) { const bf16* src_ = ksb[i_] ? Kb + kb_ * ldkb + kso[i_] : Ka + kb_ * ldka + kso[i_]; \
            __builtin_amdgcn_global_load_lds((const unsigned*)src_, (LAS unsigned*)(K_lds + (buf_) * SHM_K + i_ * 8192 + ldsw), 16, 0, 0); } \
        _Pragma("unroll") for (int i_ = 0; i_ < NVI; ++i_) \
            __builtin_amdgcn_global_load_lds((const unsigned*)(V + kb_ * ldv + vso[i_]), (LAS unsigned*)(V_lds + (buf_) * SHM_V + i_ * 8192 + ldsw), 16, 0, 0); } while (0)
    float m_reg = -1e30f, l_reg = 0.f; f32x16 o[4];
#pragma unroll
    for (int d = 0; d < 4; ++d)
#pragma unroll
        for (int r = 0; r < 16; ++r) o[d][r] = 0.f;
    const int kbase_lane = KROWB * r32 + ((hi * 16) ^ ((r32 & 7) << 4));
    const int vb0 = (int)(unsigned)(size_t)(V_lds) + v_rd_base(lane);
    const int qpos = P0 + wid * 32 + r32;
    FA_ISSUE(0, 0);
    __syncthreads();
    for (int t = 0; t < NT; ++t) {
        const int buf = t & 1;
        if (t + 1 < NT) FA_ISSUE(t + 1, buf ^ 1);
        f32x16 p0, p1;
#pragma unroll
        for (int r = 0; r < 16; ++r) { p0[r] = 0.f; p1[r] = 0.f; }
        { LAS unsigned char* kt = K_lds + buf * SHM_K;
#pragma unroll
          for (int d0 = 0; d0 < NQ; ++d0) {
              const int off = (((d0 * 2) & ~7) << 4) + ((((d0 * 2) & 7) << 4 | (hi << 4)) ^ ((r32 & 7) << 4));
              const bf16x8 b0 = *(const LAS bf16x8*)(kt + KROWB * r32 + off), b1 = *(const LAS bf16x8*)(kt + KROWB * (32 + r32) + off);
              p0 = __builtin_amdgcn_mfma_f32_32x32x16_bf16(b0, qr[d0], p0, 0, 0, 0);
              p1 = __builtin_amdgcn_mfma_f32_32x32x16_bf16(b1, qr[d0], p1, 0, 0, 0); } }
        if (CAUSAL && t * 64 + 63 > P0 + wid * 32) {
            const int dq = qpos - t * 64 - 4 * hi; const float NEG = -__builtin_inff();
#pragma unroll
            for (int r = 0; r < 16; ++r) { const int c = (r & 3) + 8 * (r >> 2); if (dq - c < 0) p0[r] = NEG; if (dq - c - 32 < 0) p1[r] = NEG; }
        }
        float pmax = p0[0];
#pragma unroll
        for (int r = 1; r < 16; ++r) pmax = fmaxf(pmax, p0[r]);
#pragma unroll
        for (int r = 0; r < 16; ++r) pmax = fmaxf(pmax, p1[r]);
        { auto rr = __builtin_amdgcn_permlane32_swap(__float_as_uint(pmax), __float_as_uint(pmax), false, false); pmax = fmaxf(__uint_as_float(rr[0]), __uint_as_float(rr[1])); }
        float alpha = 1.f;
        if (!__all(pmax - m_reg <= 11.0f)) { const float mn = fmaxf(m_reg, pmax); alpha = __builtin_amdgcn_exp2f(m_reg - mn); m_reg = mn; }
        float ps = 0.f;
#pragma unroll
        for (int r = 0; r < 16; ++r) { p0[r] = __builtin_amdgcn_exp2f(p0[r] - m_reg); p1[r] = __builtin_amdgcn_exp2f(p1[r] - m_reg); ps += p0[r] + p1[r]; }
        { auto rr = __builtin_amdgcn_permlane32_swap(__float_as_uint(ps), __float_as_uint(ps), false, false); ps = __uint_as_float(rr[0]) + __uint_as_float(rr[1]); }
        l_reg = l_reg * alpha + ps;
        if (__any(alpha < 1.f)) { if (hi == 0) al_l[r32] = alpha; asm volatile("s_waitcnt lgkmcnt(0)" ::: "memory");
#pragma unroll
            for (int d = 0; d < 4; ++d)
#pragma unroll
                for (int r = 0; r < 16; ++r) o[d][r] *= al_l[crow(r, hi)];
            asm volatile("s_waitcnt lgkmcnt(0)" ::: "memory"); }
        bf16x8 pa0, pa1, pa2, pa3;
#define FA_PK4(P, B_, OUT) do { unsigned a0 = cvtpk(P[B_ + 0], P[B_ + 1]), a1 = cvtpk(P[B_ + 2], P[B_ + 3]); unsigned b0 = cvtpk(P[B_ + 4], P[B_ + 5]), b1 = cvtpk(P[B_ + 6], P[B_ + 7]); \
        auto r0 = __builtin_amdgcn_permlane32_swap(a0, b0, false, false); auto r1 = __builtin_amdgcn_permlane32_swap(a1, b1, false, false); \
        u32x4 w = {r0[0], r1[0], r0[1], r1[1]}; OUT = *reinterpret_cast<bf16x8*>(&w); } while (0)
        FA_PK4(p0, 0, pa0); FA_PK4(p0, 8, pa1); FA_PK4(p1, 0, pa2); FA_PK4(p1, 8, pa3);
#undef FA_PK4
        { const int vb = vb0 + buf * SHM_V;
          pv_one<0>(o[0], vb, pa0, pa1, pa2, pa3); pv_one<1>(o[1], vb, pa0, pa1, pa2, pa3); pv_one<2>(o[2], vb, pa0, pa1, pa2, pa3); pv_one<3>(o[3], vb, pa0, pa1, pa2, pa3); }
        __syncthreads();
    }
#undef FA_ISSUE
    if (hi == 0) li_l[r32] = l_reg; asm volatile("s_waitcnt lgkmcnt(0)" ::: "memory");
    bf16* Ow = O + (size_t)(wid * 32) * ldo;
#pragma unroll
    for (int r = 0; r < 16; ++r) { const int orow = crow(r, hi); const float rl = __builtin_amdgcn_rcpf(li_l[orow]);
#pragma unroll
        for (int d0 = 0; d0 < 4; ++d0) { const float v = o[d0][r] * rl; const float vn = __shfl_xor(v, 1);
            if ((r32 & 1) == 0) *(unsigned*)(Ow + (size_t)orow * ldo + d0 * 32 + r32) = cvtpk(v, vn); } }
    __syncthreads();
    (void)kbase_lane;
}
}
template <class SrcCol, class KScale>
__device__ __forceinline__ void tr_item(const float* W, int ldw, int K, bf16* WT, LAS float* scr, int item, int nblk, int lane, SrcCol srccol, KScale ksc, float csc = 1.f) {
    const int kb = item / nblk, nb = item % nblk, k0 = 64 * kb, n0 = 32 * nb;
    const int sc_ = srccol(n0 + (lane & 31));
#pragma unroll 8
    for (int i = 0; i < 32; ++i) { const int kk = 2 * i + (lane >> 5); scr[kk * 33 + (lane & 31)] = sc_ >= 0 ? W[(size_t)(k0 + kk) * ldw + sc_] * ksc(k0 + kk) * csc : 0.f; }
    asm volatile("s_waitcnt lgkmcnt(0)" ::: "memory");
    const int c = lane & 7;
#pragma unroll
    for (int j = 0; j < 4; ++j) { const int n = (lane >> 3) + 8 * j; const LAS float* sp = scr + (8 * c) * 33 + n;
        pg8::u32x4 o; o.x = pg8::cvt_pk_bf16(sp[0 * 33], sp[1 * 33]); o.y = pg8::cvt_pk_bf16(sp[2 * 33], sp[3 * 33]); o.z = pg8::cvt_pk_bf16(sp[4 * 33], sp[5 * 33]); o.w = pg8::cvt_pk_bf16(sp[6 * 33], sp[7 * 33]);
        *(pg8::u32x4*)(WT + (size_t)(n0 + n) * K + k0 + 8 * c) = o; }
    asm volatile("s_waitcnt lgkmcnt(0)" ::: "memory");
}


__device__ __forceinline__ void tr_item_gu(const float* Wg, const float* Wu, bf16* WT, LAS float* scr, int item, int lane) {
    const int kb = item >> 4, nb = item & 15, k0 = 64 * kb, n0 = 32 * nb;
    const int np = n0 + (lane & 31), q = np >> 3, w = np & 7; const float* W = (w < 4 ? Wg : Wu) + 4 * q + (w & 3);
#pragma unroll 8
    for (int i = 0; i < 32; ++i) { const int kk = 2 * i + (lane >> 5); scr[kk * 33 + (lane & 31)] = W[(size_t)(k0 + kk) * 256]; }
    asm volatile("s_waitcnt lgkmcnt(0)" ::: "memory");
    const int c = lane & 7;
#pragma unroll
    for (int j = 0; j < 4; ++j) { const int n = (lane >> 3) + 8 * j; const LAS float* sp = scr + (8 * c) * 33 + n;
        pg8::u32x4 o; o.x = pg8::cvt_pk_bf16(sp[0 * 33], sp[1 * 33]); o.y = pg8::cvt_pk_bf16(sp[2 * 33], sp[3 * 33]); o.z = pg8::cvt_pk_bf16(sp[4 * 33], sp[5 * 33]); o.w = pg8::cvt_pk_bf16(sp[6 * 33], sp[7 * 33]);
        *(pg8::u32x4*)(WT + (size_t)(n0 + n) * 1024 + k0 + 8 * c) = o; }
    asm volatile("s_waitcnt lgkmcnt(0)" ::: "memory");
}
struct Args { const float* in[28]; float* out; unsigned char* ws; int ph_lo, ph_hi; };

constexpr int LDS_BYTES = 147456;
constexpr int N_PHASES = 13;

__global__ void __launch_bounds__(NTHREADS, 2) fwd(Args args) {
    extern __shared__ __attribute__((aligned(16))) unsigned char lds_raw[];
    LAS unsigned char* lds = (LAS unsigned char*)lds_raw;
    LAS float* sm = (LAS float*)lds;
    LAS float* wsm = (LAS float*)(lds + 16384);
    volatile LAS unsigned* MISC = (volatile LAS unsigned*)(lds + 131072 + 320);
    const int tid = threadIdx.x, lane = tid & 63, wave = tid >> 6, G = gridDim.x;
    const int gw = blockIdx.x * NWAVES + wave, NGW = G * NWAVES;
    unsigned char* ws = args.ws;
    unsigned* ctl = (unsigned*)(ws + WS_CTL);
    if (tid < 32) MISC[tid] = 0u;
    __syncthreads();
    XcdBarrier bar = xcd_barrier_post(ctl + CW_BAR, MISC + 8);
    const int lo = args.ph_lo, hi = args.ph_hi;
#define IN(k) (lo <= (k) && (k) < hi)
#ifndef PH_MASK
#define PH_MASK 0xffff
#endif
#define PHEN(k) (((PH_MASK) >> (k)) & 1)
#ifndef FASTMASK
#define FASTMASK 0xec
#endif
#define FAST(k) (((FASTMASK) >> (k)) & 1)
#ifndef G1MASK
#define G1MASK 0x3f
#endif
#ifndef X2_DELAY_US
#define X2_DELAY_US 0
#define W1_TEST 0
#define DBL_BAR 1
#endif
#ifndef E6ORDER
#define E6ORDER 0
#endif
#define NG1(g) (E6ORDER || !FAST(0) || !(((G1MASK) >> (g)) & 1))
#define PH_LOCALS int tid = threadIdx.x; asm volatile("" : "+v"(tid)); const int lane = tid & 63, wave = __builtin_amdgcn_readfirstlane(tid >> 6), gw = blockIdx.x * NWAVES + wave; (void)lane; (void)gw;
#define SEAM(k) do { if (IN(k) && IN((k) + 1)) xcd_barrier(bar); } while (0)

#define xin (args.in[0])
#define memin (args.in[1])
#define mix_g (args.in[3])
#define w_in (args.in[4])
#define gate_b (args.in[5])
#define q_g (args.in[6])
#define w_uq (args.in[7])
#define kv_g (args.in[8])
#define w_uk (args.in[9])
#define w_uv (args.in[10])
#define pool_w (args.in[11])
#define pool_scale (args.in[12])
#define mem_g (args.in[13])
#define w_mem_kv (args.in[14])
#define w_br_pool (args.in[15])
#define w_br_mla (args.in[16])
#define w_br_mem (args.in[17])
#define w_out (args.in[18])
#define ffn_g (args.in[19])
#define w_rg (args.in[20])
#define b_rg (args.in[21])
#define w_re (args.in[22])
#define b_re (args.in[23])
#define w_gate_e (args.in[24])
#define w_up_e (args.in[25])
#define w_down_e (args.in[26])
#define final_g (args.in[27])
#define positions ((const int*)args.in[2])
#define ropeC ((float*)(ws + WS_ROPEC))
#define ropeS ((float*)(ws + WS_ROPES))
#define rsq ((float*)(ws + WS_RSQ))
#define rskv ((float*)(ws + WS_RSKV))
#define aw ((float*)(ws + WS_AW))
#define mkv ((bf16*)(ws + WS_MKV))
#define memn ((bf16*)(ws + WS_MEMN))
#define kr ((bf16*)(ws + WS_KR))
#define list ((int*)(ws + WS_LIST))
#define hb ((bf16*)(ws + WS_A))
#define qn ((bf16*)(ws + WS_A))
#define ymla ((bf16*)(ws + WS_A))
#define h2 ((bf16*)(ws + WS_A))
#define gates ((bf16*)(ws + WS_GATES))
#define hg ((float*)(ws + WS_HG))
#define hmid ((bf16*)(ws + WS_HMID))
#define pxq ((bf16*)(ws + WS_PXQ))
#define qkvd ((bf16*)(ws + WS_QKVD))
#define pp ((bf16*)(ws + WS_P))
#define qr ((bf16*)(ws + WS_QR))
#define merged ((bf16*)(ws + WS_MERGED))
#define yslot ((bf16*)(ws + WS_YSLOT))
#define kn ((bf16*)args.out)
#define vv ((bf16*)args.out + (size_t)T * D)
#define m32 (args.out)
#define x1 (args.out)
#define Wt_gu ((bf16*)(ws + WS_WGU))
#define Wt_d ((bf16*)(ws + WS_WD))
#define hmid2 ((bf16*)(ws + WS_HMID2))
#define Wt_in ((bf16*)(ws + WS_WIN))
#define Wt_uq ((bf16*)(ws + WS_WUQ))
#define Wt_ukv ((bf16*)(ws + WS_WUKV))
#define Wt_out ((bf16*)(ws + WS_WOUT))
#define Wt_brmla ((bf16*)(ws + WS_WBRMLA))
#define Wt_memkv ((bf16*)(ws + WS_WMEMKV))
#define Wt_brpool ((bf16*)(ws + WS_WBRPOOL))
#define Wt_brmem ((bf16*)(ws + WS_WBRMEM))
    unsigned* cnt = ctl + CW_CNT;
    int toff = 0;

    if (PHEN(0) && IN(0)) {
        PH_LOCALS
        for (int r = gw; r < T + MROWS; r += NGW) {
            const bool is_x = r < T; const float* src = is_x ? xin + (size_t)r * D : memin + (size_t)(r - T) * D;
            const float* g = is_x ? mix_g : mem_g; bf16* dst = is_x ? hb + (size_t)r * D : memn + (size_t)(r - T) * D;
            float v[16]; float s = 0.f;
#pragma unroll
            for (int j = 0; j < 4; ++j) { const f32x4 q = *(const f32x4*)(src + j * 256 + lane * 4); v[4*j] = q[0]; v[4*j+1] = q[1]; v[4*j+2] = q[2]; v[4*j+3] = q[3]; s += q[0]*q[0] + q[1]*q[1] + q[2]*q[2] + q[3]*q[3]; }
            const float rs = 1.0f / sqrtf(wave_sum(s) * (1.f / D) + RMS_EPS);
#pragma unroll
            for (int j = 0; j < 4; ++j)
#pragma unroll
                for (int i = 0; i < 4; ++i) { const int c = j * 256 + lane * 4 + i; dst[c] = f2bf(v[4*j+i] * rs * g[c]); }
        }
        for (int i = blockIdx.x * NTHREADS + tid; i < T * 32; i += G * NTHREADS) {
            const int t = i >> 5, f = i & 31;
            const double inv = pow(10000.0, -(double)(2 * f) / 64.0);
            const float invf = (float)inv;
            const float ang = (float)positions[t] * invf;
            ropeC[i] = (float)cos((double)ang); ropeS[i] = (float)sin((double)ang);
        }
    }
    if (PHEN(0) && IN(0)) {
        PH_LOCALS
        LAS float* scr = (LAS float*)(lds + wave * 16384);
        constexpr int I_IN = 16 * (NPAD_IN / 32), I_UQ = 6 * 48, I_UKV = 4 * 64, I_SQ = 16 * 32, I_HALF = 8 * 32;
        constexpr int NIT = I_IN + I_UQ + I_UKV + 3 * I_SQ + 2 * I_HALF;
        auto one = [](int) { return 1.f; };
        for (int it = gw; it < NIT; it += NGW) {
            int r = it;
            if (r < I_IN) { const int nb = r % (NPAD_IN / 32);
                tr_item(w_in, DIN, 1024, Wt_in, scr, r, NPAD_IN / 32, lane, [](int n) {
                    if (n < 512) return n; if (n < 1024) return 1216 + (n - 512); if (n < 4096) return 1728 + (n - 1024); if (n < 4480) return 512 + (n - 4096);
                    if (n < 4736) return 896 + (n - 4480); if (n < 4800) return 1152 + (n - 4736); return -1; }, one, (nb >= 16 && nb < 32) ? QSCALE_MEM : 1.f); continue; } r -= I_IN;
            if (r < I_UQ) { const float* g = q_g; tr_item(w_uq, 1536, 384, Wt_uq, scr, r, 48, lane, [](int n) {
                    if (n < 1024) return (n >> 7) * 192 + (n & 127); const int q = n - 1024, hh = q >> 6, j = q & 63; return hh * 192 + 128 + (j >> 1) + 32 * (j & 1); }, [g](int k) { return g[k]; }); continue; } r -= I_UQ;
            if (r < I_UKV) { const float* g = kv_g; const int nb = r % 64;
                if (nb < 32) tr_item(w_uk, 1024, 256, Wt_ukv, scr, r, 64, lane, [](int n) { return n; }, [g](int k) { return g[k]; });
                else tr_item(w_uv - 1024, 1024, 256, Wt_ukv, scr, r, 64, lane, [](int n) { return n; }, [g](int k) { return g[k]; });
                continue; } r -= I_UKV;
            if (r < I_SQ) { tr_item(w_mem_kv, 1024, 1024, Wt_memkv, scr, r, 32, lane, [](int n) { return n; }, one); continue; } r -= I_SQ;
            if (r < I_SQ) { tr_item(w_br_mla, 1024, 1024, Wt_brmla, scr, r, 32, lane, [](int n) { return n; }, one); continue; } r -= I_SQ;
            if (r < I_SQ) { tr_item(w_out, 1024, 1024, Wt_out, scr, r, 32, lane, [](int n) { return n; }, one); continue; } r -= I_SQ;
            if (r < I_HALF) { if (!FAST(7)) tr_item(w_br_pool, 1024, 512, Wt_brpool, scr, r, 32, lane, [](int n) { return n; }, one); continue; } r -= I_HALF;
            tr_item(w_br_mem, 1024, 512, Wt_brmem, scr, r, 32, lane, [](int n) { return n; }, one);
        }
    }
    if (PHEN(0) && IN(0) && FAST(7)) {
        for (int g = 0; g < 4; ++g)
            ngemm(sm, 128, 1024, 128, toff,
                  [&](int m, int k) { return pool_w[(size_t)g * 16384 + m * 128 + k] * pool_scale[g * 128 + k]; },
                  [&](int k, int n) { return w_br_pool[(size_t)(g * 128 + k) * 1024 + n]; },
                  [&](int m, int n, float a) { Wt_brpool[(size_t)n * 512 + g * 128 + m] = f2bf(a); });
    }
    SEAM(0);
#if defined(X2_DELAY_US) && X2_DELAY_US > 0
    { const unsigned long long t0 = __builtin_amdgcn_s_memrealtime(); while (__builtin_amdgcn_s_memrealtime() - t0 < (unsigned long long)X2_DELAY_US * 100ull) __builtin_amdgcn_s_sleep(16); }
    __syncthreads();
#endif
    if (PHEN(1) && IN(1)) {
        PH_LOCALS
        { pg8::Gemm g{hb, Wt_in, T, 1024, 1024, 1024, 1024}; pg8::StaticOrder So; So.init(T, 1024, G, (int)blockIdx.x);
          pg8::EpiStore E{pxq, 1024};
          pg8::gemm_phase<pg8::EpiStore, pg8::StaticOrder, PG8_ALIGN, PG8_SP2>(lds, g, So, E); }
        { pg8::Gemm g{hb, Wt_in + (size_t)1024 * 1024, T, 3072, 1024, 1024, 1024}; pg8::StaticOrder So; So.init(T, 3072, G, (int)blockIdx.x);
          pg8::EpiStore E{gates, 3072};
          pg8::gemm_phase<pg8::EpiStore, pg8::StaticOrder, PG8_ALIGN, PG8_SP2>(lds, g, So, E); }
        { pg8::Gemm g{hb, Wt_in + (size_t)4096 * 1024, T, 768, 1024, 1024, 1024}; pg8::StaticOrder So; So.init(T, 768, G, (int)blockIdx.x);
          pg8::EpiStore E{qkvd, 768};
          pg8::gemm_phase<pg8::EpiStore, pg8::StaticOrder, PG8_ALIGN, PG8_SP2>(lds, g, So, E); }
        { pg8::Gemm g{memn, Wt_memkv, MROWS, 1024, 1024, 1024, 1024}; pg8::StaticOrder So; So.init(MROWS, 1024, G, ((int)blockIdx.x + G - 192) % G);
          pg8::EpiStore E{mkv, 1024};
          pg8::gemm_phase<pg8::EpiStore, pg8::StaticOrder, PG8_ALIGN, PG8_SP2>(lds, g, So, E); }
    }
    SEAM(1);
    if (PHEN(2) && IN(2)) {
        PH_LOCALS
        for (int t = gw; t < T; t += NGW) {
            const bf16* qk = qkvd + (size_t)t * 768;
            float s1 = 0.f;
#pragma unroll
            for (int j = 0; j < 6; ++j) { const float v = bf2f(qk[j * 64 + lane]); s1 += v * v; }
            s1 = wave_sum(s1);
            float s2 = 0.f;
#pragma unroll
            for (int j = 0; j < 4; ++j) { const float v = bf2f(qk[384 + j * 64 + lane]); s2 += v * v; }
            s2 = wave_sum(s2);
            if (lane == 0) { rsq[t] = 1.0f / sqrtf(s1 * (1.f / 384.f) + RMS_EPS); rskv[t] = 1.0f / sqrtf(s2 * (1.f / 256.f) + RMS_EPS); }
            if (lane < 32) {
                const float a = bf2f(qk[640 + lane]), b = bf2f(qk[672 + lane]), c = ropeC[t * 32 + lane], sn = ropeS[t * 32 + lane];
                kr[(size_t)t * 64 + lane] = f2bf(a * c - b * sn); kr[(size_t)t * 64 + 32 + lane] = f2bf(b * c + a * sn);
            }
            const int sidx = t & (S - 1);
#pragma unroll
            for (int j = 0; j < 8; ++j) {
                const int c = j * 64 + lane, g = c >> 7, w = 2 << g;
                const int n = (sidx + 1 < w) ? sidx + 1 : w;
                float sum = 0.f;
                for (int i = 0; i < n; ++i) sum += bf2f(pxq[(size_t)(t - i) * 1024 + c]);
                pp[(size_t)t * 512 + c] = f2bf(sum / (float)n - bf2f(pxq[(size_t)t * 1024 + c]));
            }
        }
    }
    SEAM(2);
    if (PHEN(3) && IN(3)) {
        PH_LOCALS
        { pg8::Gemm g{qkvd, Wt_uq, T, 1536, 384, 768, 384}; pg8::StaticOrder So; So.init(T, 1536, G, (int)blockIdx.x);
          pg8::EpiQ E{qn, qr, rsq, ropeC, ropeS};
          pg8::gemm_phase<pg8::EpiQ, pg8::StaticOrder, PG8_ALIGN, PG8_SP2>(lds, g, So, E); }
        { pg8::Gemm g{qkvd + 384, Wt_ukv, T, 2048, 256, 768, 256}; pg8::StaticOrder So; So.init(T, 2048, G, G - 1 - (int)blockIdx.x);
          pg8::EpiKV E{kn, vv, rskv};
          pg8::gemm_phase<pg8::EpiKV, pg8::StaticOrder, PG8_ALIGN, PG8_SP2>(lds, g, So, E); }
    }
    SEAM(3);
    if (PHEN(5) && IN(5) && FAST(5)) {
        for (int L = (int)blockIdx.x; L < 256; L += G) {
            const int bh = L >> 3, x = L & 7, b = bh >> 3, h = bh & 7;
#pragma unroll 1
            for (int pass = 0; pass < 2; ++pass) {
                const int qb = pass ? x : 15 - x; const size_t row0 = (size_t)b * S + (size_t)qb * 256, k0 = (size_t)b * S;
                fa::attn_block<12, true>(qn + row0 * 1024 + h * 128, 1024, qr + row0 * 512 + h * 64, 512, kn + k0 * 1024 + h * 128, 1024, kr + k0 * 64, 64,
                                         vv + k0 * 1024 + h * 128, 1024, ymla + row0 * 1024 + h * 128, 1024, qb * 256, S, lds);
            }
        }
        for (int L = (int)blockIdx.x; L < 256; L += G) {
            const int b = L >> 6, h = (L >> 4) & 3, qb = L & 15; const size_t row0 = (size_t)b * S + (size_t)qb * 256, k0 = (size_t)b * MEMLEN;
            fa::attn_block<8, false>(pxq + row0 * 1024 + 512 + h * 128, 1024, nullptr, 0, mkv + k0 * 1024 + h * 128, 1024, nullptr, 0,
                                     mkv + k0 * 1024 + 512 + h * 128, 1024, pxq + row0 * 1024 + 512 + h * 128, 1024, 0, MEMLEN, lds);
        }
    }
    if (PHEN(5) && IN(5) && !FAST(5)) {
        PH_LOCALS
        LAS float* qs = wsm + wave * 256;
        for (int task = gw; task < T * 8; task += NGW) {
            const int t = task >> 3, hh = task & 7, b = t >> 12, sidx = t & (S - 1);
            qs[lane] = bf2f(qn[(size_t)t * 1024 + hh * 128 + lane]); qs[64 + lane] = bf2f(qn[(size_t)t * 1024 + hh * 128 + 64 + lane]);
            qs[128 + lane] = bf2f(qr[(size_t)t * 512 + hh * 64 + lane]);
            asm volatile("s_waitcnt lgkmcnt(0)" ::: "memory");
            float m_run = -1e30f, l_run = 0.f, o0 = 0.f, o1 = 0.f;
            for (int j0 = 0; j0 <= sidx; j0 += 64) {
                asm volatile("" ::: "memory");
                const int key = j0 + lane; const bool valid = key <= sidx; const size_t kt = (size_t)(b * S + (valid ? key : sidx));
                float sc = 0.f;
                const bf16* kp = kn + kt * 1024 + hh * 128;
#pragma unroll 2
                for (int k = 0; k < 128; k += 8) { const uint4 w = *(const uint4*)(kp + k); const unsigned ww[4] = {w.x, w.y, w.z, w.w};
#pragma unroll
                    for (int i = 0; i < 4; ++i) { sc += qs[k + 2*i] * __uint_as_float(ww[i] << 16) + qs[k + 2*i + 1] * __uint_as_float(ww[i] & 0xffff0000u); } }
                const bf16* rp = kr + kt * 64;
#pragma unroll 2
                for (int k = 0; k < 64; k += 8) { const uint4 w = *(const uint4*)(rp + k); const unsigned ww[4] = {w.x, w.y, w.z, w.w};
#pragma unroll
                    for (int i = 0; i < 4; ++i) { sc += qs[128 + k + 2*i] * __uint_as_float(ww[i] << 16) + qs[128 + k + 2*i + 1] * __uint_as_float(ww[i] & 0xffff0000u); } }
                if (!valid) sc = -1e30f;
                const float mn = fmaxf(m_run, wave_max(sc));
                const float alpha = exp2f(m_run - mn);
                const float p = valid ? exp2f(sc - mn) : 0.f;
                l_run = l_run * alpha + wave_sum(p); o0 *= alpha; o1 *= alpha; m_run = mn;
                const int nk = (sidx - j0 + 1 < 64) ? sidx - j0 + 1 : 64;
                for (int j = 0; j < nk; ++j) {
                    const float pj = __shfl(p, j);
                    const unsigned w = *(const unsigned*)(vv + (size_t)(b * S + j0 + j) * 1024 + hh * 128 + lane * 2);
                    o0 += pj * __uint_as_float(w << 16); o1 += pj * __uint_as_float(w & 0xffff0000u);
                }
            }
            const float il = 1.f / l_run;
            *(unsigned*)(ymla + (size_t)t * 1024 + hh * 128 + lane * 2) = (unsigned)f2bf(o0 * il) | ((unsigned)f2bf(o1 * il) << 16);
        }
        for (int task = gw; task < T * 4; task += NGW) {
            const int t = task >> 2, hh = task & 3, b = t >> 12;
            qs[lane] = bf2f(pxq[(size_t)t * 1024 + 512 + hh * 128 + lane]); qs[64 + lane] = bf2f(pxq[(size_t)t * 1024 + 512 + hh * 128 + 64 + lane]);
            asm volatile("s_waitcnt lgkmcnt(0)" ::: "memory");
            float m_run = -1e30f, l_run = 0.f, o0 = 0.f, o1 = 0.f;
            for (int j0 = 0; j0 < MEMLEN; j0 += 64) {
                asm volatile("" ::: "memory");
                const size_t kt = (size_t)(b * MEMLEN + j0 + lane);
                float sc = 0.f;
                const bf16* kp = mkv + kt * 1024 + hh * 128;
#pragma unroll 2
                for (int k = 0; k < 128; k += 8) { const uint4 w = *(const uint4*)(kp + k); const unsigned ww[4] = {w.x, w.y, w.z, w.w};
#pragma unroll
                    for (int i = 0; i < 4; ++i) { sc += qs[k + 2*i] * __uint_as_float(ww[i] << 16) + qs[k + 2*i + 1] * __uint_as_float(ww[i] & 0xffff0000u); } }
                const float mn = fmaxf(m_run, wave_max(sc));
                const float alpha = exp2f(m_run - mn);
                const float p = exp2f(sc - mn);
                l_run = l_run * alpha + wave_sum(p); o0 *= alpha; o1 *= alpha; m_run = mn;
                for (int j = 0; j < 64; ++j) {
                    const float pj = __shfl(p, j);
                    const unsigned w = *(const unsigned*)(mkv + (size_t)(b * MEMLEN + j0 + j) * 1024 + 512 + hh * 128 + lane * 2);
                    o0 += pj * __uint_as_float(w << 16); o1 += pj * __uint_as_float(w & 0xffff0000u);
                }
            }
            const float il = 1.f / l_run;
            *(unsigned*)(pxq + (size_t)t * 1024 + 512 + hh * 128 + lane * 2) = (unsigned)f2bf(o0 * il) | ((unsigned)f2bf(o1 * il) << 16);
        }
    }
    SEAM(5);
    if (PHEN(6) && IN(6) && !FAST(7)) {
        PH_LOCALS
        for (int g = 0; g < 4; ++g)
            ngemm(sm, T, 128, 128, toff,
                  [&](int m, int k) { return bf2f(pp[(size_t)m * 512 + g * 128 + k]); },
                  [&](int k, int n) { return pool_w[(size_t)g * 16384 + k * 128 + n]; },
                  [&](int m, int n, float a) { pxq[(size_t)m * 1024 + g * 128 + n] = f2bf(a * pool_scale[g * 128 + n]); });
    }
    if (!FAST(7)) SEAM(6);
    if (PHEN(7) && IN(7)) {
        PH_LOCALS
        if (FAST(2)) {
        pg8::StaticOrder So; So.init(T, 1024, G, (int)blockIdx.x);
        { pg8::Gemm g{FAST(7) ? pp : pxq, Wt_brpool, T, 1024, 512, FAST(7) ? 512 : 1024, 512}; pg8::EpiGate<0> E{gates, gate_b, 0, m32, merged};
          pg8::gemm_phase<pg8::EpiGate<0>, pg8::StaticOrder, PG8_ALIGN, PG8_SP2>(lds, g, So, E); }
        { pg8::Gemm g{ymla, Wt_brmla, T, 1024, 1024, 1024, 1024}; pg8::EpiGate<1> E{gates, gate_b, 1024, m32, merged};
          pg8::gemm_phase<pg8::EpiGate<1>, pg8::StaticOrder, PG8_ALIGN, PG8_SP2>(lds, g, So, E); }
        { pg8::Gemm g{pxq + 512, Wt_brmem, T, 1024, 512, 1024, 512}; pg8::EpiGate<2> E{gates, gate_b, 2048, m32, merged};
          pg8::gemm_phase<pg8::EpiGate<2>, pg8::StaticOrder, PG8_ALIGN, PG8_SP2>(lds, g, So, E); }
        } else {
        auto gate = [&](int m, int j) { return 1.f / (1.f + __expf(-(bf2f(gates[(size_t)m * 3072 + j]) + gate_b[j]))); };
        int to = toff;
        ngemm(sm, T, D, 512, to,
              [&](int m, int k) { return bf2f(pxq[(size_t)m * 1024 + k]); },
              [&](int k, int n) { return w_br_pool[(size_t)k * D + n]; },
              [&](int m, int n, float a) { m32[(size_t)m * D + n] = a * gate(m, n); });
        to = toff;
        ngemm(sm, T, D, 1024, to,
              [&](int m, int k) { return bf2f(ymla[(size_t)m * 1024 + k]); },
              [&](int k, int n) { return w_br_mla[(size_t)k * D + n]; },
              [&](int m, int n, float a) { m32[(size_t)m * D + n] += a * gate(m, 1024 + n); });
        to = toff;
        ngemm(sm, T, D, 512, to,
              [&](int m, int k) { return bf2f(pxq[(size_t)m * 1024 + 512 + k]); },
              [&](int k, int n) { return w_br_mem[(size_t)k * D + n]; },
              [&](int m, int n, float a) { merged[(size_t)m * D + n] = f2bf(m32[(size_t)m * D + n] + a * gate(m, 2048 + n)); });
        toff = to;
        }
    }
    SEAM(7);
    if (PHEN(8) && IN(8)) {
        PH_LOCALS
        if (FAST(3)) {
        pg8::Gemm g{merged, Wt_out, T, 1024, 1024, 1024, 1024}; pg8::StaticOrder So; So.init(T, 1024, G, (int)blockIdx.x);
        pg8::EpiRes E{xin, x1};
        pg8::gemm_phase<pg8::EpiRes, pg8::StaticOrder, PG8_ALIGN, PG8_SP2>(lds, g, So, E);
        } else {
        ngemm(sm, T, D, D, toff,
              [&](int m, int k) { return bf2f(merged[(size_t)m * D + k]); },
              [&](int k, int n) { return w_out[(size_t)k * D + n]; },
              [&](int m, int n, float a) { x1[(size_t)m * D + n] = xin[(size_t)m * D + n] + a; });
        }
    }
    SEAM(8);
    if (PHEN(9) && IN(9)) {
        PH_LOCALS
        for (int t = gw; t < T; t += NGW) {
            float s = 0.f;
#pragma unroll
            for (int j = 0; j < 4; ++j) { const f32x4 q = *(const f32x4*)(x1 + (size_t)t * D + j * 256 + lane * 4); s += q[0]*q[0] + q[1]*q[1] + q[2]*q[2] + q[3]*q[3]; }
            const float rs = 1.0f / sqrtf(wave_sum(s) * (1.f / D) + RMS_EPS);
            float lg[36];
#pragma unroll
            for (int c = 0; c < 36; ++c) lg[c] = 0.f;
#pragma unroll 1
            for (int j = 0; j < 4; ++j) {
                const f32x4 q = *(const f32x4*)(x1 + (size_t)t * D + j * 256 + lane * 4);
                const f32x4 gq = *(const f32x4*)(ffn_g + j * 256 + lane * 4);
#pragma unroll
                for (int i = 0; i < 4; ++i) { const int k = j * 256 + lane * 4 + i; const float hv = q[i] * rs * gq[i];
                    h2[(size_t)t * D + k] = f2bf(hv);
                    const f32x4 wg = *(const f32x4*)(w_rg + (size_t)k * 4);
                    lg[0] += hv * wg[0]; lg[1] += hv * wg[1]; lg[2] += hv * wg[2]; lg[3] += hv * wg[3];
#pragma unroll
                    for (int c4 = 0; c4 < 8; ++c4) { const f32x4 we = *(const f32x4*)(w_re + (size_t)k * 32 + c4 * 4);
                        lg[4 + c4*4] += hv * we[0]; lg[5 + c4*4] += hv * we[1]; lg[6 + c4*4] += hv * we[2]; lg[7 + c4*4] += hv * we[3]; } }
            }
#pragma unroll
            for (int c = 0; c < 36; ++c) lg[c] = wave_sum(lg[c]);
            int gi = 0; float gmax = lg[0] + b_rg[0];
#pragma unroll
            for (int c = 1; c < 4; ++c) { const float l = lg[c] + b_rg[c]; if (l > gmax) { gmax = l; gi = c; } }
            float gden = 0.f;
#pragma unroll
            for (int c = 0; c < 4; ++c) gden += __expf(lg[c] + b_rg[c] - gmax);
            const float p_g = 1.f / gden;
            float el[8];
#pragma unroll
            for (int c = 0; c < 8; ++c) { float val = 0.f;
#pragma unroll
                for (int g2 = 0; g2 < 4; ++g2) val = (gi == g2) ? lg[4 + g2 * 8 + c] + b_re[g2 * 8 + c] : val;
                el[c] = val; }
            int i1 = 0; float l1 = el[0];
#pragma unroll
            for (int c = 1; c < 8; ++c) if (el[c] > l1) { l1 = el[c]; i1 = c; }
            int i2 = -1; float l2 = -3.0e38f;
#pragma unroll
            for (int c = 0; c < 8; ++c) if (c != i1 && el[c] > l2) { l2 = el[c]; i2 = c; }
            const float r = __expf(l2 - l1);
            const float w1 = p_g / (1.f + r), w2 = p_g * r / (1.f + r);
            if (lane == 0) {
                const int e1 = gi * 8 + i1, e2 = gi * 8 + i2;
                const unsigned p1 = atomicAdd(&cnt[e1], 1u); list[e1 * T + p1] = t * 2;
                const unsigned p2 = atomicAdd(&cnt[e2], 1u); list[e2 * T + p2] = t * 2 + 1;
                aw[t * 2] = w1; aw[t * 2 + 1] = w2;
            }
        }
    }
    if (PHEN(9) && IN(9) && FAST(6)) {
        PH_LOCALS
        LAS float* scr = (LAS float*)(lds + wave * 16384);
        for (int it = gw; it < NE * 384; it += NGW) {
            const int e = it / 384, r = it - e * 384;
            if (r < 256) tr_item_gu(w_gate_e + (size_t)e * D * DE, w_up_e + (size_t)e * D * DE, Wt_gu + (size_t)e * 512 * 1024, scr, r, lane);
            else tr_item(w_down_e + (size_t)e * DE * D, 1024, 256, Wt_d + (size_t)e * 1024 * 256, scr, r - 256, 32, lane, [](int n) { return n; }, [](int) { return 1.f; });
        }
    }
    SEAM(9);
    if (FAST(6) && ((PHEN(10) && IN(10)) || (PHEN(11) && IN(11)))) {
        LAS int* tab = (LAS int*)(lds + TAB_OFF);
        if (threadIdx.x == 0) { int rb = 0; for (int e = 0; e < NE; ++e) { const int nb = ((int)cnt[e] + 255) >> 8; for (int k = 0; k < nb; ++k) tab[rb++] = e | (k << 8); } tab[191] = rb; }
        __syncthreads();
    }
    if (PHEN(10) && IN(10) && FAST(6)) {
        const LAS int* tab = (const LAS int*)(lds + TAB_OFF); const int nrb = __builtin_amdgcn_readfirstlane(tab[191]);
        pg8::Gemm g{h2, Wt_gu, nrb * 256, NE * 512, 1024, 1024, 1024}; pg8::MoeOrder So{tab, nrb, 2, G, (int)blockIdx.x, list, cnt};
        pg8::EpiMoeUp E{hmid2};
        pg8::gemm_phase_g<pg8::EpiMoeUp, pg8::MoeOrder>(lds, g, So, E);
    }
    if (FAST(6)) SEAM(10);
    if (PHEN(11) && IN(11) && FAST(6)) {
        const LAS int* tab = (const LAS int*)(lds + TAB_OFF); const int nrb = __builtin_amdgcn_readfirstlane(tab[191]);
        pg8::Gemm g{hmid2, Wt_d, nrb * 256, NE * 1024, 256, 256, 256}; pg8::MoeOrder So{tab, nrb, 4, G, (int)blockIdx.x, list, cnt};
        pg8::EpiMoeDown E{yslot, list, cnt, aw, tab};
        pg8::gemm_phase<pg8::EpiMoeDown, pg8::MoeOrder, PG8_ALIGN, PG8_SP2>(lds, g, So, E);
    }
    if (FAST(6)) SEAM(11);
    if (PHEN(10) && IN(10) && !FAST(6)) {
        PH_LOCALS
        int base = 0;
        for (int e = 0; e < NE; ++e) {
            const int ne = (int)cnt[e]; const int* le = list + e * T;
            const float* wg = w_gate_e + (size_t)e * D * DE; const float* wu = w_up_e + (size_t)e * D * DE;
            int to = toff;
            ngemm(sm, ne, DE, D, to,
                  [&](int m, int k) { return bf2f(h2[(size_t)(le[m] >> 1) * D + k]); },
                  [&](int k, int n) { return wg[(size_t)k * DE + n]; },
                  [&](int m, int n, float a) { hg[(size_t)(base + m) * DE + n] = a; });
            to = toff;
            ngemm(sm, ne, DE, D, to,
                  [&](int m, int k) { return bf2f(h2[(size_t)(le[m] >> 1) * D + k]); },
                  [&](int k, int n) { return wu[(size_t)k * DE + n]; },
                  [&](int m, int n, float a) { const float gg = hg[(size_t)(base + m) * DE + n]; hmid[(size_t)(base + m) * DE + n] = f2bf(gg / (1.f + __expf(-gg)) * a); });
            toff = to; base += ne;
        }
    }
    if (!FAST(6)) SEAM(10);
    if (PHEN(11) && IN(11) && !FAST(6)) {
        PH_LOCALS
        int base = 0;
        for (int e = 0; e < NE; ++e) {
            const int ne = (int)cnt[e]; const int* le = list + e * T;
            const float* wd = w_down_e + (size_t)e * DE * D;
            ngemm(sm, ne, D, DE, toff,
                  [&](int m, int k) { return bf2f(hmid[(size_t)(base + m) * DE + k]); },
                  [&](int k, int n) { return wd[(size_t)k * D + n]; },
                  [&](int m, int n, float a) { const int as = le[m]; yslot[(size_t)as * D + n] = f2bf(aw[as] * a); });
            base += ne;
        }
    }
    if (!FAST(6)) SEAM(11);
    if (PHEN(12) && IN(12)) {
        PH_LOCALS
        for (int t = gw; t < T; t += NGW) {
            float v[16]; float s = 0.f;
#pragma unroll
            for (int j = 0; j < 4; ++j) { const int c = j * 256 + lane * 4; const f32x4 q = *(const f32x4*)(x1 + (size_t)t * D + c);
                const uint2 y0 = *(const uint2*)(yslot + (size_t)(2 * t) * D + c), y1 = *(const uint2*)(yslot + (size_t)(2 * t + 1) * D + c);
                v[4*j]   = q[0] + __uint_as_float(y0.x << 16) + __uint_as_float(y1.x << 16);
                v[4*j+1] = q[1] + __uint_as_float(y0.x & 0xffff0000u) + __uint_as_float(y1.x & 0xffff0000u);
                v[4*j+2] = q[2] + __uint_as_float(y0.y << 16) + __uint_as_float(y1.y << 16);
                v[4*j+3] = q[3] + __uint_as_float(y0.y & 0xffff0000u) + __uint_as_float(y1.y & 0xffff0000u);
                s += v[4*j]*v[4*j] + v[4*j+1]*v[4*j+1] + v[4*j+2]*v[4*j+2] + v[4*j+3]*v[4*j+3]; }
            const float rs = 1.0f / sqrtf(wave_sum(s) * (1.f / D) + RMS_EPS);
#pragma unroll
            for (int j = 0; j < 4; ++j) { const int c = j * 256 + lane * 4; const f32x4 g = *(const f32x4*)(final_g + c);
                f32x4 o; o[0] = v[4*j] * rs * g[0]; o[1] = v[4*j+1] * rs * g[1]; o[2] = v[4*j+2] * rs * g[2]; o[3] = v[4*j+3] * rs * g[3];
                *(f32x4*)(args.out + (size_t)t * D + c) = o; }
        }
    }
#undef IN
#undef SEAM
}

extern "C" void kernel_launch(void* const* d_in, const int* in_sizes, int n_in, void* d_out, int out_size, void* d_ws, size_t ws_size, hipStream_t stream) {
    static int grid = 0;
    if (grid == 0) {
        if (n_in != 28 || out_size != T * D || ws_size < WS_END) { fprintf(stderr, "kernel_launch: unexpected shapes n_in %d out %d ws %zu\n", n_in, out_size, ws_size); grid = -1; return; }
        int dev = 0, cus = 0, per_cu = 0;
        if (hipGetDevice(&dev) != hipSuccess || hipDeviceGetAttribute(&cus, hipDeviceAttributeMultiprocessorCount, dev) != hipSuccess) { grid = -1; return; }
        if (hipFuncSetAttribute((const void*)fwd, hipFuncAttributeMaxDynamicSharedMemorySize, LDS_BYTES) != hipSuccess) { fprintf(stderr, "hipFuncSetAttribute failed\n"); grid = -1; return; }
        if (hipOccupancyMaxActiveBlocksPerMultiprocessor(&per_cu, (const void*)fwd, NTHREADS, LDS_BYTES) != hipSuccess || per_cu < 1) fprintf(stderr, "occupancy query: %d\n", per_cu);
        (void)hipGetLastError();
        grid = cus;
    }
    if (grid < 0) return;
    (void)hipMemsetAsync((char*)d_ws + WS_CTL, 0, CTL_ZERO_BYTES, stream);
    Args a{};
    for (int i = 0; i < 28; ++i) a.in[i] = (const float*)d_in[i];
    a.out = (float*)d_out; a.ws = (unsigned char*)d_ws; a.ph_lo = 0; a.ph_hi = N_PHASES;
    hipLaunchKernelGGL(fwd, dim3(grid), dim3(NTHREADS), LDS_BYTES, stream, a);
}
```

```cpp
#include <hip/hip_runtime.h>
#include <cstdio>
#include <cstdint>

#define LAS __attribute__((address_space(3)))
typedef unsigned short bf16;
typedef float f32x4 __attribute__((ext_vector_type(4)));

constexpr int NB = 4, S = 4096, T = NB * S, D = 1024, DIN = 4800, MEMLEN = 256, MROWS = NB * MEMLEN;
constexpr int NE = 32, DE = 256;
constexpr float RMS_EPS = 1e-6f;
constexpr int NWAVES = 8, NTHREADS = 512;
constexpr float QSCALE_MLA = 0.07216878364870322f * 1.4426950408889634f;
constexpr float QSCALE_MEM = 0.08838834764831845f * 1.4426950408889634f;

constexpr size_t MiB = 1u << 20;
constexpr size_t WS_CTL = 0, CTL_ZERO_BYTES = 1 * MiB;
constexpr size_t KiB = 1u << 10;
constexpr size_t WS_BCNT = 512 * KiB, WS_ERANK = 576 * KiB, WS_RS2 = 704 * KiB;
constexpr size_t WS_ROPEC = 1 * MiB, WS_ROPES = 3 * MiB, WS_RSQ = 5 * MiB, WS_RSKV = 5 * MiB + 64 * KiB, WS_AW = 6 * MiB + 768 * KiB;
constexpr size_t WS_MKV = 7 * MiB, WS_MEMN = 9 * MiB, WS_KR = 11 * MiB, WS_LIST = 13 * MiB, WS_WBRMEM = 15 * MiB;
constexpr size_t WS_WIN = 224 * MiB;
constexpr size_t WS_WUQ = 240 * MiB, WS_WUKV = WS_WUQ + 1152 * KiB, WS_WOUT = WS_WUKV + 1 * MiB, WS_WBRMLA = WS_WOUT + 2 * MiB,
                 WS_WMEMKV = WS_WBRMLA + 2 * MiB, WS_WBRPOOL = WS_WMEMKV + 2 * MiB;
static_assert(WS_WBRPOOL + 1 * MiB <= 256 * MiB, "weights fit");
constexpr int NPAD_IN = 4864;
constexpr size_t WS_A = 24 * MiB;
constexpr size_t WS_GATES = 56 * MiB;
constexpr size_t WS_HG = 56 * MiB, WS_HMID = 88 * MiB;
constexpr size_t WS_WGU = 56 * MiB, WS_WD = 88 * MiB, WS_HMID2 = 104 * MiB;
constexpr int GSM_OFF = 147456, MISC_OFF = 151552, LCNT_OFF = 151680, TAB_OFF = 151808, OFFS_OFF = 152576;
constexpr size_t WS_PXQ = 152 * MiB;
constexpr size_t WS_QKVD = 184 * MiB;
constexpr size_t WS_QR = 208 * MiB;
constexpr size_t WS_P = 224 * MiB;
constexpr size_t WS_MERGED = 184 * MiB;
constexpr size_t WS_YSLOT = 152 * MiB;
constexpr size_t WS_END = 256 * MiB;
constexpr int CW_BAR = 4096, CW_CNT = 1024;

__device__ __forceinline__ float bf2f(bf16 v) { return __uint_as_float(((unsigned)v) << 16); }
__device__ __forceinline__ bf16 f2bf(float f) { unsigned u = __float_as_uint(f); u += 0x7fffu + ((u >> 16) & 1u); return (bf16)(u >> 16); }
__device__ __forceinline__ float wave_sum(float v) {
#pragma unroll
    for (int o = 1; o < 64; o <<= 1) v += __shfl_xor(v, o);
    return v;
}
__device__ __forceinline__ float wave_max(float v) {
#pragma unroll
    for (int o = 1; o < 64; o <<= 1) v = fmaxf(v, __shfl_xor(v, o));
    return v;
}

#define XB_TMO      128
#define XB_XCNT(j)  (256  + 64 * (j))
#define XB_XSUB(j)  (1280 + 64 * (j))
#define XB_XGEN(j)  (2304 + 64 * (j))
#define XB_TOP      3328
#define XB_TOPGEN   3392
#define XCD_BAR_WORDS 3456
#define XB_SPIN_CAP (1u << 18)

__device__ __forceinline__ unsigned xb_ld(unsigned* p)              { return __hip_atomic_load(p, __ATOMIC_RELAXED, __HIP_MEMORY_SCOPE_AGENT); }
__device__ __forceinline__ unsigned xb_add(unsigned* p, unsigned v) { return __hip_atomic_fetch_add(p, v, __ATOMIC_RELAXED, __HIP_MEMORY_SCOPE_AGENT); }
__device__ __forceinline__ unsigned xb_xcc_id() { return (unsigned)__builtin_amdgcn_s_getreg((3 << 11) | 20) & 0xFu; }
#define XB_SPIN(cond, bar) do { unsigned _sp = 0; while (cond) { __builtin_amdgcn_s_sleep(1); \
    if ((++_sp & 255u) == 0u) { if (xb_ld(&(bar)[XB_TMO])) break; if (_sp > XB_SPIN_CAP) { atomicAdd(&(bar)[XB_TMO], 1u); break; } } } } while (0)

struct XcdBarrier { unsigned* bar; unsigned x; volatile LAS unsigned* st; };

__device__ __forceinline__ XcdBarrier xcd_barrier_post(unsigned* bar, volatile LAS unsigned* st) {
    XcdBarrier b; b.bar = bar; b.x = xb_xcc_id(); b.st = st;
    if (threadIdx.x == 0) (void)xb_add(&bar[XB_XCNT(b.x)], 1u);
    return b;
}
__device__ __forceinline__ void xcd_barrier_complete(unsigned* bar, unsigned x, unsigned& nloc, unsigned& nx) {
    const unsigned G = gridDim.x * gridDim.y * gridDim.z;
    unsigned sum, cnt, mine, sp = 0u;
    for (;;) {
        sum = 0u; cnt = 0u; mine = 0u;
#pragma unroll
        for (unsigned j = 0; j < 16; ++j) { const unsigned c = xb_ld(&bar[XB_XCNT(j)]); sum += c; cnt += (c > 0u) ? 1u : 0u; mine = (j == x) ? c : mine; }
        if (sum == G) break;
        __builtin_amdgcn_s_sleep(1);
        if ((++sp & 255u) == 0u) { if (xb_ld(&bar[XB_TMO])) break; if (sp > XB_SPIN_CAP) { atomicAdd(&bar[XB_TMO], 1u); break; } }
    }
    nloc = mine > 0u ? mine : 1u; nx = cnt > 0u ? cnt : 1u;
}
__device__ __forceinline__ void xcd_barrier(const XcdBarrier& b) {
    asm volatile("s_waitcnt vmcnt(0)" ::: "memory");
    __syncthreads();
    if (threadIdx.x == 0) {
        unsigned* bar = b.bar;
        __builtin_amdgcn_s_waitcnt(0);
        unsigned nloc = b.st[0], nx = b.st[1];
        if (nloc == 0u) { xcd_barrier_complete(bar, b.x, nloc, nx); b.st[0] = nloc; b.st[1] = nx; }
        const unsigned old = xb_add(&bar[XB_XSUB(b.x)], 1u);
        const unsigned gen = old / nloc;
        if (old + 1u == (gen + 1u) * nloc) {
            __builtin_amdgcn_fence(__ATOMIC_RELEASE, "agent");
            asm volatile("s_waitcnt vmcnt(0)" ::: "memory");
            const unsigned og = xb_add(&bar[XB_TOP], 1u);
            const unsigned tg = og / nx;
            if (og + 1u == (tg + 1u) * nx) xb_add(&bar[XB_TOPGEN], 1u);
            else XB_SPIN(xb_ld(&bar[XB_TOPGEN]) == tg, bar);
            __builtin_amdgcn_fence(__ATOMIC_ACQUIRE, "agent");
            asm volatile("buffer_inv sc0 sc1" ::: "memory");
            asm volatile("s_waitcnt vmcnt(0)" ::: "memory");
            xb_add(&bar[XB_XGEN(b.x)], 1u);
            asm volatile("s_waitcnt vmcnt(0)" ::: "memory");
        } else {
            XB_SPIN(xb_ld(&bar[XB_XGEN(b.x)]) == gen, bar);
            __builtin_amdgcn_fence(__ATOMIC_ACQUIRE, "agent");
            asm volatile("s_waitcnt vmcnt(0)" ::: "memory");
        }
    }
    __syncthreads();
}

template <class FA, class FB, class FE>
__device__ __forceinline__ void ngemm(LAS float* sm, int M, int N, int K, int& tile_off, FA fa, FB fb, FE fe) {
    LAS float* As = sm;
    LAS float* Bs = sm + 16 * 65 + 15;
    Bs = sm + 1040;
    const int tid = threadIdx.x, ty = tid >> 4, tx = tid & 15, G = gridDim.x;
    const int tn = (N + 63) / 64, tm = (M + 63) / 64, tiles = tn * tm;
    int first = ((int)blockIdx.x - (tile_off % G) + G) % G;
    for (int t = first; t < tiles; t += G) {
        const int m0 = (t / tn) * 64, n0 = (t % tn) * 64;
        float acc[2][4];
#pragma unroll
        for (int i = 0; i < 2; ++i)
#pragma unroll
            for (int j = 0; j < 4; ++j) acc[i][j] = 0.f;
        for (int k0 = 0; k0 < K; k0 += 16) {
            __syncthreads();
#pragma unroll
            for (int j = 0; j < 2; ++j) {
                const int idx = tid + 512 * j;
                { const int m = idx >> 4, k = idx & 15; As[k * 65 + m] = (m0 + m < M) ? fa(m0 + m, k0 + k) : 0.f; }
                { const int k = idx >> 6, n = idx & 63; Bs[k * 64 + n] = (n0 + n < N) ? fb(k0 + k, n0 + n) : 0.f; }
            }
            __syncthreads();
#pragma unroll
            for (int k = 0; k < 16; ++k) {
                const float a0 = As[k * 65 + ty * 2], a1 = As[k * 65 + ty * 2 + 1];
                const f32x4 b = *(const LAS f32x4*)(Bs + k * 64 + tx * 4);
                acc[0][0] += a0 * b[0]; acc[0][1] += a0 * b[1]; acc[0][2] += a0 * b[2]; acc[0][3] += a0 * b[3];
                acc[1][0] += a1 * b[0]; acc[1][1] += a1 * b[1]; acc[1][2] += a1 * b[2]; acc[1][3] += a1 * b[3];
            }
        }
#pragma unroll
        for (int i = 0; i < 2; ++i)
#pragma unroll
            for (int j = 0; j < 4; ++j) { const int m = m0 + ty * 2 + i, n = n0 + tx * 4 + j; if (m < M && n < N) fe(m, n, acc[i][j]); }
    }
    tile_off += tiles;
}


#ifndef PG8_AUX
#define PG8_AUX 0
#endif
namespace pg8 {
#define PG8_LAS __attribute__((address_space(3)))
typedef unsigned short bf16_t;
typedef short bf16x8 __attribute__((ext_vector_type(8)));
typedef float f32x4 __attribute__((ext_vector_type(4)));
typedef unsigned u32x4 __attribute__((ext_vector_type(4)));
constexpr int BM = 256, BK = 64, HALF = 128, HTB = HALF * BK * 2  , STAGE_BYTES = 8 * HTB, NXCD = 8, WGM = 8;

__host__ __device__ __forceinline__ int lds_byte(int r, int c) { const int st = (r >> 4) * 2 + (c >> 5), rr = r & 15, cc = c & 31, ob = rr * 64 + cc * 2; return st * 1024 + (ob ^ (((ob >> 9) & 1) << 5)); }
__host__ __device__ __forceinline__ void stage_rc(int b, int& R, int& C) { const int st = b / 1024, sb = b % 1024, swz = sb ^ (((sb >> 9) & 1) << 5); R = (st >> 1) * 16 + swz / 64; C = (st & 1) * 32 + (swz % 64) / 2; }
__host__ __device__ __forceinline__ int perm32(int rho) { const int n = rho >> 4, i = rho & 15; return 8 * (i >> 2) + 4 * n + (i & 3); }

struct Unit { int pm, pn; };
struct Gemm { const bf16_t* A; const bf16_t* Bt; int M, N, K, lda, ldb; };

struct StaticOrder {
    int nM, nN, nwg, G, c;
    __host__ __device__ void init(int M, int N, int G_, int c_) { nM = M / BM; nN = N / BM; nwg = nM * nN; G = G_; c = c_; }
    __host__ __device__ bool next(int i, Unit& u) const {
        const long L = (long)i * G + c; if (L >= nwg) return false;
        int wgid = (int)L; { const int q = nwg / NXCD, r = nwg % NXCD, xcd = wgid % NXCD, off = wgid / NXCD; wgid = (xcd < r ? xcd * (q + 1) : r * (q + 1) + (xcd - r) * q) + off; }
        const int nig = WGM * nN, gid = wgid / nig, fm = gid * WGM, gsz = (nM - fm) < WGM ? (nM - fm) : WGM;
        u.pm = fm + ((wgid % nig) % gsz); u.pn = (wgid % nig) / gsz; return true;
    }
    __device__ __forceinline__ void a_ready(const Unit&) const {}
    __device__ __forceinline__ void done(const Unit&) const {}
};

__device__ __forceinline__ unsigned cvt_pk_bf16(float lo, float hi) { unsigned r; asm volatile("v_cvt_pk_bf16_f32 %0, %1, %2" : "=v"(r) : "v"(lo), "v"(hi)); return r; }

template <class Epi, class Sched, bool ALIGN_EPI = false, bool SP2 = false>
__device__ __forceinline__ void gemm_phase(PG8_LAS unsigned char* lds, const Gemm g, const Sched& S, const Epi& E) {
    const int tid = threadIdx.x, wid = __builtin_amdgcn_readfirstlane(tid >> 6), lane = tid & 63, wr = wid >> 2, wc = wid & 3, fr = lane & 15, fq = lane >> 4;
    const int K = g.K, nt = K / BK;
    unsigned voffA[2], voffB[2];
#pragma unroll
    for (int i = 0; i < 2; ++i) { int R, C; stage_rc(tid * 16 + i * 8192, R, C); const int Rb = Epi::PERM ? ((R & ~31) + perm32(R & 31)) : R;
        voffA[i] = (unsigned)(R * g.lda + C) * 2u; voffB[i] = (unsigned)(Rb * g.ldb + C) * 2u; }
    const size_t kstep = (size_t)(BK * 2);
    const size_t hstepA = (size_t)HALF * g.lda * 2, hstepB = (size_t)HALF * g.ldb * 2;
    const size_t tstepA = 2 * hstepA, tstepB = 2 * hstepB;
    const unsigned ldsw = (unsigned)wid * 1024u;
    const int aoff = lds_byte(wr * 64 + fr, fq * 8), boff = lds_byte(wc * 32 + fr, fq * 8);
#define PG8_SA(b, h) (((b) * 2 + (h)) * HTB)
#define PG8_SB(b, h) ((4 + (b) * 2 + (h)) * HTB)
#define PG8_STAGE(bufoff, gbase, voff) do { _Pragma("unroll") for (int _i = 0; _i < 2; ++_i) \
        __builtin_amdgcn_global_load_lds((const unsigned*)((const char*)(gbase) + (voff)[_i]), (PG8_LAS unsigned*)(lds + (bufoff) + ldsw + _i * 8192), 16, 0, PG8_AUX); } while (0)
#define PG8_LDA(dst, b, h) do { _Pragma("unroll") for (int m = 0; m < 4; ++m) _Pragma("unroll") for (int k = 0; k < 2; ++k) dst[m][k] = *(const PG8_LAS bf16x8*)(lds + PG8_SA(b, h) + aoff + m * 2048 + k * 1024); } while (0)
#define PG8_LDB(dst, b, h) do { _Pragma("unroll") for (int n = 0; n < 2; ++n) _Pragma("unroll") for (int k = 0; k < 2; ++k) dst[n][k] = *(const PG8_LAS bf16x8*)(lds + PG8_SB(b, h) + boff + n * 2048 + k * 1024); } while (0)
#define PG8_MMA(ai, bj, At, Bt) do { __builtin_amdgcn_s_setprio(1); _Pragma("unroll") for (int m = 0; m < 4; ++m) _Pragma("unroll") for (int n = 0; n < 2; ++n) _Pragma("unroll") for (int k = 0; k < 2; ++k) \
        acc[ai][bj][m][n] = __builtin_amdgcn_mfma_f32_16x16x32_bf16(Bt[n][k], At[m][k], acc[ai][bj][m][n], 0, 0, 0); __builtin_amdgcn_s_setprio(0); } while (0)
#define PG8_WAIT_V(n) asm volatile("s_waitcnt vmcnt(" #n ")" ::: "memory")
#define PG8_WAIT_L(n) asm volatile("s_waitcnt lgkmcnt(" #n ")" ::: "memory")
#define PG8_BAR __builtin_amdgcn_s_barrier()
#define PG8_SCHED __builtin_amdgcn_sched_barrier(0)
    Unit cur, nxt; int ui = 0;
    if (!S.next(0, cur)) return;
    f32x4 acc[2][2][4][2];
#pragma unroll
    for (int a = 0; a < 2; ++a)
#pragma unroll
        for (int b = 0; b < 2; ++b)
#pragma unroll
            for (int m = 0; m < 4; ++m)
#pragma unroll
                for (int n = 0; n < 2; ++n) acc[a][b][m][n] = (f32x4){0.f, 0.f, 0.f, 0.f};
    bf16x8 At[4][2], B0[2][2], B1[2][2];
    const char* cA = (const char*)g.A + (size_t)cur.pm * tstepA; const char* cB = (const char*)g.Bt + (size_t)cur.pn * tstepB;
    S.a_ready(cur);
    if constexpr (SP2) {
        PG8_STAGE(PG8_SB(0, 0), cB, voffB); PG8_STAGE(PG8_SB(0, 1), cB + hstepB, voffB); PG8_STAGE(PG8_SA(0, 0), cA, voffA); PG8_STAGE(PG8_SA(0, 1), cA + hstepA, voffA);
        if (wr == 1) PG8_BAR;
        PG8_WAIT_V(2); PG8_BAR;
        PG8_STAGE(PG8_SB(1, 0), cB + kstep, voffB); PG8_STAGE(PG8_SA(1, 0), cA + kstep, voffA); PG8_STAGE(PG8_SB(1, 1), cB + hstepB + kstep, voffB);
        PG8_WAIT_V(6); PG8_BAR;
    } else {
        PG8_STAGE(PG8_SB(0, 0), cB, voffB); PG8_STAGE(PG8_SA(0, 0), cA, voffA); PG8_STAGE(PG8_SB(0, 1), cB + hstepB, voffB); PG8_STAGE(PG8_SA(0, 1), cA + hstepA, voffA);
        if (wr == 1) PG8_BAR;
        PG8_WAIT_V(4); PG8_BAR;
        PG8_STAGE(PG8_SB(1, 0), cB + kstep, voffB); PG8_STAGE(PG8_SA(1, 0), cA + kstep, voffA); PG8_STAGE(PG8_SB(1, 1), cB + hstepB + kstep, voffB);
        PG8_WAIT_V(6); PG8_BAR;
    }
    for (;;) {
        const bool has_next = S.next(ui + 1, nxt);
        const char* nA = has_next ? (const char*)g.A + (size_t)nxt.pm * tstepA : cA; const char* nB = has_next ? (const char*)g.Bt + (size_t)nxt.pn * tstepB : cB;
#pragma unroll 1
        for (int t = 0; t < nt; t += 2) {
            const bool last = (t == nt - 2);
            const char* a1 = cA + (size_t)(t + 1) * kstep;
            const char* a2 = last ? nA : cA + (size_t)(t + 2) * kstep; const char* b2 = last ? nB : cB + (size_t)(t + 2) * kstep;
            const char* a3 = a2 + kstep; const char* b3 = b2 + kstep;
            if (last && has_next) S.a_ready(nxt);
            if constexpr (SP2) {
            PG8_LDB(B0, 0, 0); PG8_LDB(B1, 0, 1); PG8_SCHED; PG8_LDA(At, 0, 0); PG8_STAGE(PG8_SA(1, 1), a1 + hstepA, voffA);
            PG8_WAIT_V(8); PG8_WAIT_L(0); PG8_BAR; PG8_MMA(0, 0, At, B0); PG8_MMA(0, 1, At, B1); PG8_BAR; PG8_SCHED;
            PG8_LDA(At, 0, 1); PG8_STAGE(PG8_SB(0, 0), b2, voffB); PG8_STAGE(PG8_SB(0, 1), b2 + hstepB, voffB); PG8_STAGE(PG8_SA(0, 0), a2, voffA);
            PG8_WAIT_V(8); PG8_WAIT_L(0); PG8_BAR; PG8_MMA(1, 0, At, B0); PG8_MMA(1, 1, At, B1); PG8_BAR; PG8_SCHED;
            PG8_LDB(B0, 1, 0); PG8_LDB(B1, 1, 1); PG8_SCHED; PG8_LDA(At, 1, 0); PG8_STAGE(PG8_SA(0, 1), a2 + hstepA, voffA);
            PG8_WAIT_V(8); PG8_WAIT_L(0); PG8_BAR; PG8_MMA(0, 0, At, B0); PG8_MMA(0, 1, At, B1); PG8_BAR; PG8_SCHED;
            PG8_LDA(At, 1, 1); PG8_STAGE(PG8_SB(1, 0), b3, voffB); PG8_STAGE(PG8_SB(1, 1), b3 + hstepB, voffB); PG8_STAGE(PG8_SA(1, 0), a3, voffA);
            PG8_WAIT_V(8); PG8_WAIT_L(0); PG8_BAR; PG8_MMA(1, 0, At, B0); PG8_MMA(1, 1, At, B1); PG8_BAR; PG8_SCHED;
            } else {
            PG8_LDB(B0, 0, 0); PG8_SCHED; PG8_LDA(At, 0, 0); PG8_STAGE(PG8_SA(1, 1), a1 + hstepA, voffA);
            PG8_WAIT_L(8); PG8_BAR; PG8_WAIT_L(0); PG8_MMA(0, 0, At, B0); PG8_BAR; PG8_SCHED;
            PG8_LDB(B1, 0, 1); PG8_STAGE(PG8_SB(0, 0), b2, voffB);
            PG8_BAR; PG8_WAIT_L(0); PG8_MMA(0, 1, At, B1); PG8_BAR;
            PG8_LDA(At, 0, 1); PG8_STAGE(PG8_SA(0, 0), a2, voffA);
            PG8_BAR; PG8_WAIT_L(0); PG8_MMA(1, 0, At, B0); PG8_BAR; PG8_SCHED;
            PG8_STAGE(PG8_SB(0, 1), b2 + hstepB, voffB);
            PG8_WAIT_V(6); PG8_BAR; PG8_MMA(1, 1, At, B1); PG8_BAR;
            PG8_LDB(B0, 1, 0); PG8_SCHED; PG8_LDA(At, 1, 0); PG8_STAGE(PG8_SA(0, 1), a2 + hstepA, voffA);
            PG8_WAIT_L(8); PG8_BAR; PG8_WAIT_L(0); PG8_MMA(0, 0, At, B0); PG8_BAR; PG8_SCHED;
            PG8_LDB(B1, 1, 1); PG8_STAGE(PG8_SB(1, 0), b3, voffB);
            PG8_BAR; PG8_WAIT_L(0); PG8_MMA(0, 1, At, B1); PG8_BAR;
            PG8_LDA(At, 1, 1); PG8_STAGE(PG8_SA(1, 0), a3, voffA);
            PG8_BAR; PG8_WAIT_L(0); PG8_MMA(1, 0, At, B0); PG8_BAR; PG8_SCHED;
            PG8_STAGE(PG8_SB(1, 1), b3 + hstepB, voffB);
            PG8_WAIT_V(6); PG8_BAR; PG8_MMA(1, 1, At, B1); PG8_BAR;
            }
        }
        if constexpr (ALIGN_EPI) { if (wr == 0) PG8_BAR; }
        if constexpr (!Epi::AFTER_DRAIN) { E(acc, cur, wr, wc, fr, fq); S.done(cur); }
        if (!has_next) break;
#pragma unroll
        for (int a = 0; a < 2; ++a)
#pragma unroll
            for (int b = 0; b < 2; ++b)
#pragma unroll
                for (int m = 0; m < 4; ++m)
#pragma unroll
                    for (int n = 0; n < 2; ++n) acc[a][b][m][n] = (f32x4){0.f, 0.f, 0.f, 0.f};
        cur = nxt; cA = nA; cB = nB; ++ui;
        if constexpr (ALIGN_EPI) { if (wr == 1) PG8_BAR; }
    }
    PG8_WAIT_V(0);
    if constexpr (!ALIGN_EPI) { if (wr == 0) PG8_BAR; }
    PG8_BAR;
    if constexpr (Epi::AFTER_DRAIN) { E.fused(acc, cur, wr, wc, fr, fq, lds, wid, lane); S.done(cur); }
#undef PG8_SA
#undef PG8_SB
#undef PG8_STAGE
#undef PG8_LDA
#undef PG8_LDB
#undef PG8_MMA
#undef PG8_WAIT_V
#undef PG8_WAIT_L
#undef PG8_BAR
#undef PG8_SCHED
}

template <class Epi, class Sched>
__device__ __forceinline__ void gemm_phase_g(PG8_LAS unsigned char* lds, const Gemm g, const Sched& S, const Epi& E) {
    const int tid = threadIdx.x, wid = __builtin_amdgcn_readfirstlane(tid >> 6), lane = tid & 63, wr = wid >> 2, wc = wid & 3, fr = lane & 15, fq = lane >> 4;
    const int K = g.K, nt = K / BK;
    unsigned voffB[2]; int RA[2], CA[2];
#pragma unroll
    for (int i = 0; i < 2; ++i) { int R, C; stage_rc(tid * 16 + i * 8192, R, C); const int Rb = Epi::PERM ? ((R & ~31) + perm32(R & 31)) : R;
        RA[i] = R; CA[i] = C * 2; voffB[i] = (unsigned)(Rb * g.ldb + C) * 2u; }
    const size_t kstep = (size_t)(BK * 2);
    const size_t hstepB = (size_t)HALF * g.ldb * 2, tstepB = 2 * hstepB;
    const unsigned ldsw = (unsigned)wid * 1024u;
    const int aoff = lds_byte(wr * 64 + fr, fq * 8), boff = lds_byte(wc * 32 + fr, fq * 8);
#define PG8_SA(b, h) (((b) * 2 + (h)) * HTB)
#define PG8_SB(b, h) ((4 + (b) * 2 + (h)) * HTB)
#define PG8_STAGE(bufoff, gbase, voff) do { _Pragma("unroll") for (int _i = 0; _i < 2; ++_i) \
        __builtin_amdgcn_global_load_lds((const unsigned*)((const char*)(gbase) + (voff)[_i]), (PG8_LAS unsigned*)(lds + (bufoff) + ldsw + _i * 8192), 16, 0, PG8_AUX); } while (0)
#define PG8_LDA(dst, b, h) do { _Pragma("unroll") for (int m = 0; m < 4; ++m) _Pragma("unroll") for (int k = 0; k < 2; ++k) dst[m][k] = *(const PG8_LAS bf16x8*)(lds + PG8_SA(b, h) + aoff + m * 2048 + k * 1024); } while (0)
#define PG8_LDB(dst, b, h) do { _Pragma("unroll") for (int n = 0; n < 2; ++n) _Pragma("unroll") for (int k = 0; k < 2; ++k) dst[n][k] = *(const PG8_LAS bf16x8*)(lds + PG8_SB(b, h) + boff + n * 2048 + k * 1024); } while (0)
#define PG8_MMA(ai, bj, At, Bt) do { __builtin_amdgcn_s_setprio(1); _Pragma("unroll") for (int m = 0; m < 4; ++m) _Pragma("unroll") for (int n = 0; n < 2; ++n) _Pragma("unroll") for (int k = 0; k < 2; ++k) \
        acc[ai][bj][m][n] = __builtin_amdgcn_mfma_f32_16x16x32_bf16(Bt[n][k], At[m][k], acc[ai][bj][m][n], 0, 0, 0); __builtin_amdgcn_s_setprio(0); } while (0)
#define PG8_WAIT_V(n) asm volatile("s_waitcnt vmcnt(" #n ")" ::: "memory")
#define PG8_WAIT_L(n) asm volatile("s_waitcnt lgkmcnt(0)" ::: "memory")
#define PG8_BAR __builtin_amdgcn_s_barrier()
#define PG8_SCHED __builtin_amdgcn_sched_barrier(0)
#define PG8_ROWOFFS(u_, v0_, v1_) do { _Pragma("unroll") for (int _i = 0; _i < 2; ++_i) { \
        v0_[_i] = (unsigned)S.a_tok(u_, RA[_i]) * (unsigned)(g.lda * 2) + (unsigned)CA[_i]; v1_[_i] = (unsigned)S.a_tok(u_, RA[_i] + HALF) * (unsigned)(g.lda * 2) + (unsigned)CA[_i]; } } while (0)
    Unit cur, nxt; int ui = 0;
    if (!S.next(0, cur)) return;
    f32x4 acc[2][2][4][2];
#pragma unroll
    for (int a = 0; a < 2; ++a)
#pragma unroll
        for (int b = 0; b < 2; ++b)
#pragma unroll
            for (int m = 0; m < 4; ++m)
#pragma unroll
                for (int n = 0; n < 2; ++n) acc[a][b][m][n] = (f32x4){0.f, 0.f, 0.f, 0.f};
    bf16x8 At[4][2], B0[2][2], B1[2][2];
    const char* const gA = (const char*)g.A; const char* cB = (const char*)g.Bt + (size_t)cur.pn * tstepB;
    unsigned cv0[2], cv1[2], nv0[2], nv1[2];
    PG8_ROWOFFS(cur, cv0, cv1);
    asm volatile("s_waitcnt vmcnt(0)" ::: "memory");
    PG8_STAGE(PG8_SB(0, 0), cB, voffB); PG8_STAGE(PG8_SB(0, 1), cB + hstepB, voffB); PG8_STAGE(PG8_SA(0, 0), gA, cv0); PG8_STAGE(PG8_SA(0, 1), gA, cv1);
    if (wr == 1) PG8_BAR;
    PG8_WAIT_V(2); PG8_BAR;
    PG8_STAGE(PG8_SB(1, 0), cB + kstep, voffB); PG8_STAGE(PG8_SA(1, 0), gA + kstep, cv0); PG8_STAGE(PG8_SB(1, 1), cB + hstepB + kstep, voffB);
    PG8_WAIT_V(6); PG8_BAR;
    for (;;) {
        const bool has_next = S.next(ui + 1, nxt);
        const char* nB = has_next ? (const char*)g.Bt + (size_t)nxt.pn * tstepB : cB;
        if (has_next) PG8_ROWOFFS(nxt, nv0, nv1); else { nv0[0] = cv0[0]; nv0[1] = cv0[1]; nv1[0] = cv1[0]; nv1[1] = cv1[1]; }
        asm volatile("s_waitcnt vmcnt(0)" ::: "memory");
#pragma unroll 1
        for (int t = 0; t < nt; t += 2) {
            const bool last = (t == nt - 2);
            const char* a1 = gA + (size_t)(t + 1) * kstep;
            const char* a2 = last ? gA : gA + (size_t)(t + 2) * kstep; const char* b2 = last ? nB : cB + (size_t)(t + 2) * kstep;
            const char* a3 = a2 + kstep; const char* b3 = b2 + kstep;
            unsigned s0[2], s1[2];
            s0[0] = last ? nv0[0] : cv0[0]; s0[1] = last ? nv0[1] : cv0[1]; s1[0] = last ? nv1[0] : cv1[0]; s1[1] = last ? nv1[1] : cv1[1];
            PG8_LDB(B0, 0, 0); PG8_LDB(B1, 0, 1); PG8_SCHED; PG8_LDA(At, 0, 0); PG8_STAGE(PG8_SA(1, 1), a1, cv1);
            PG8_WAIT_V(8); PG8_WAIT_L(0); PG8_BAR; PG8_MMA(0, 0, At, B0); PG8_MMA(0, 1, At, B1); PG8_BAR; PG8_SCHED;
            PG8_LDA(At, 0, 1); PG8_STAGE(PG8_SB(0, 0), b2, voffB); PG8_STAGE(PG8_SB(0, 1), b2 + hstepB, voffB); PG8_STAGE(PG8_SA(0, 0), a2, s0);
            PG8_WAIT_V(8); PG8_WAIT_L(0); PG8_BAR; PG8_MMA(1, 0, At, B0); PG8_MMA(1, 1, At, B1); PG8_BAR; PG8_SCHED;
            PG8_LDB(B0, 1, 0); PG8_LDB(B1, 1, 1); PG8_SCHED; PG8_LDA(At, 1, 0); PG8_STAGE(PG8_SA(0, 1), a2, s1);
            PG8_WAIT_V(8); PG8_WAIT_L(0); PG8_BAR; PG8_MMA(0, 0, At, B0); PG8_MMA(0, 1, At, B1); PG8_BAR; PG8_SCHED;
            PG8_LDA(At, 1, 1); PG8_STAGE(PG8_SB(1, 0), b3, voffB); PG8_STAGE(PG8_SB(1, 1), b3 + hstepB, voffB); PG8_STAGE(PG8_SA(1, 0), a3, s0);
            PG8_WAIT_V(8); PG8_WAIT_L(0); PG8_BAR; PG8_MMA(1, 0, At, B0); PG8_MMA(1, 1, At, B1); PG8_BAR; PG8_SCHED;
        }
        if (wr == 0) PG8_BAR;
        E(acc, cur, wr, wc, fr, fq);
        if (!has_next) break;
#pragma unroll
        for (int a = 0; a < 2; ++a)
#pragma unroll
            for (int b = 0; b < 2; ++b)
#pragma unroll
                for (int m = 0; m < 4; ++m)
#pragma unroll
                    for (int n = 0; n < 2; ++n) acc[a][b][m][n] = (f32x4){0.f, 0.f, 0.f, 0.f};
        cur = nxt; cB = nB; ++ui; cv0[0] = nv0[0]; cv0[1] = nv0[1]; cv1[0] = nv1[0]; cv1[1] = nv1[1];
        if (wr == 1) PG8_BAR;
    }
    PG8_WAIT_V(0);
    PG8_BAR;
#undef PG8_ROWOFFS
#undef PG8_SA
#undef PG8_SB
#undef PG8_STAGE
#undef PG8_LDA
#undef PG8_LDB
#undef PG8_MMA
#undef PG8_WAIT_V
#undef PG8_WAIT_L
#undef PG8_BAR
#undef PG8_SCHED
}
}

#define PG8_SP2 true
#define PG8_ALIGN true
namespace pg8 {
__device__ __forceinline__ void store8(bf16_t* p, f32x4 v0, f32x4 v1) { u32x4 w; w.x = cvt_pk_bf16(v0[0], v0[1]); w.y = cvt_pk_bf16(v0[2], v0[3]); w.z = cvt_pk_bf16(v1[0], v1[1]); w.w = cvt_pk_bf16(v1[2], v1[3]); *(u32x4*)p = w; }
__device__ __forceinline__ float sigm(float x) { return __builtin_amdgcn_rcpf(1.f + __builtin_amdgcn_exp2f(-1.4426950408889634f * x)); }
typedef unsigned u32x2 __attribute__((ext_vector_type(2)));
__device__ __forceinline__ void rope_store(bf16_t* p1, bf16_t* p2, f32x4 v0, f32x4 v1, f32x4 c, f32x4 s, float sc) {
    const float a0 = v0[0] * sc, b0 = v0[1] * sc, a1 = v0[2] * sc, b1 = v0[3] * sc, a2 = v1[0] * sc, b2 = v1[1] * sc, a3 = v1[2] * sc, b3 = v1[3] * sc;
    u32x2 o1, o2;
    o1.x = cvt_pk_bf16(a0 * c[0] - b0 * s[0], a1 * c[1] - b1 * s[1]); o1.y = cvt_pk_bf16(a2 * c[2] - b2 * s[2], a3 * c[3] - b3 * s[3]);
    o2.x = cvt_pk_bf16(b0 * c[0] + a0 * s[0], b1 * c[1] + a1 * s[1]); o2.y = cvt_pk_bf16(b2 * c[2] + a2 * s[2], b3 * c[3] + a3 * s[3]);
    *(u32x2*)p1 = o1; *(u32x2*)p2 = o2;
}
struct EpiStore {
    static constexpr bool PERM = true, AFTER_DRAIN = false;
    bf16_t* O; int ldc;
    __device__ __forceinline__ void operator()(const f32x4 (&acc)[2][2][4][2], const Unit& u, int wr, int wc, int fr, int fq) const {
        const int row0 = u.pm * BM + wr * 64 + fr, col0 = u.pn * BM + wc * 32 + 8 * fq;
#pragma unroll
        for (int ai = 0; ai < 2; ++ai)
#pragma unroll
            for (int m = 0; m < 4; ++m)
#pragma unroll
                for (int bj = 0; bj < 2; ++bj) store8(O + (size_t)(row0 + ai * HALF + m * 16) * ldc + col0 + bj * HALF, acc[ai][bj][m][0], acc[ai][bj][m][1]);
    }
};
struct EpiStore3 {
    static constexpr bool PERM = true, AFTER_DRAIN = false;
    bf16_t *o0, *o1, *o2;
    __device__ __forceinline__ void operator()(const f32x4 (&acc)[2][2][4][2], const Unit& u, int wr, int wc, int fr, int fq) const {
        bf16_t* O; int ldc, pn;
        if (u.pn < 4) { O = o0; ldc = 1024; pn = u.pn; } else if (u.pn < 16) { O = o1; ldc = 3072; pn = u.pn - 4; } else { O = o2; ldc = 768; pn = u.pn - 16; }
        const int row0 = u.pm * BM + wr * 64 + fr, col0 = pn * BM + wc * 32 + 8 * fq;
#pragma unroll
        for (int ai = 0; ai < 2; ++ai)
#pragma unroll
            for (int m = 0; m < 4; ++m)
#pragma unroll
                for (int bj = 0; bj < 2; ++bj) store8(O + (size_t)(row0 + ai * HALF + m * 16) * ldc + col0 + bj * HALF, acc[ai][bj][m][0], acc[ai][bj][m][1]);
    }
};
struct EpiQ {
    static constexpr bool PERM = true, AFTER_DRAIN = false;
    bf16_t *qn, *qr; const float *rsq, *ropeC, *ropeS;
    __device__ __forceinline__ void operator()(const f32x4 (&acc)[2][2][4][2], const Unit& u, int wr, int wc, int fr, int fq) const {
        const int row0 = u.pm * BM + wr * 64 + fr;
        float rsv[2][4];
#pragma unroll
        for (int ai = 0; ai < 2; ++ai)
#pragma unroll
            for (int m = 0; m < 4; ++m) rsv[ai][m] = rsq[row0 + ai * HALF + m * 16] * QSCALE_MLA;
        if (u.pn < 4) {
            bf16_t* base = qn + u.pn * BM + wc * 32 + 8 * fq;
#pragma unroll
            for (int ai = 0; ai < 2; ++ai)
#pragma unroll
                for (int m = 0; m < 4; ++m) { const int row = row0 + ai * HALF + m * 16; const float rs = rsv[ai][m];
#pragma unroll
                    for (int bj = 0; bj < 2; ++bj) store8(base + (size_t)row * 1024 + bj * HALF, acc[ai][bj][m][0] * rs, acc[ai][bj][m][1] * rs); }
        } else {
#pragma unroll
            for (int bj = 0; bj < 2; ++bj) {
                const int cb = (u.pn - 4) * BM + bj * HALF + wc * 32 + 8 * fq, hd = cb >> 6, i0 = (cb & 63) >> 1;
                bf16_t* qb = qr + hd * 64 + i0;
#pragma unroll
                for (int ai = 0; ai < 2; ++ai)
#pragma unroll
                    for (int m = 0; m < 4; ++m) { const int row = row0 + ai * HALF + m * 16;
                        const f32x4 cc = *(const f32x4*)(ropeC + (size_t)row * 32 + i0), sn = *(const f32x4*)(ropeS + (size_t)row * 32 + i0);
                        rope_store(qb + (size_t)row * 512, qb + (size_t)row * 512 + 32, acc[ai][bj][m][0], acc[ai][bj][m][1], cc, sn, rsv[ai][m]);
                        asm volatile("" ::: "memory"); }
            }
        }
    }
};
struct EpiKV {
    static constexpr bool PERM = true, AFTER_DRAIN = false;
    bf16_t *kn, *vv; const float* rskv;
    __device__ __forceinline__ void operator()(const f32x4 (&acc)[2][2][4][2], const Unit& u, int wr, int wc, int fr, int fq) const {
        const int row0 = u.pm * BM + wr * 64 + fr; bf16_t* base = (u.pn < 4 ? kn + u.pn * BM : vv + (u.pn - 4) * BM) + wc * 32 + 8 * fq;
#pragma unroll
        for (int ai = 0; ai < 2; ++ai)
#pragma unroll
            for (int m = 0; m < 4; ++m) { const int row = row0 + ai * HALF + m * 16; const float rs = rskv[row];
#pragma unroll
                for (int bj = 0; bj < 2; ++bj) store8(base + (size_t)row * 1024 + bj * HALF, acc[ai][bj][m][0] * rs, acc[ai][bj][m][1] * rs); }
    }
};
template <int MODE> struct EpiGate {
    static constexpr bool PERM = true, AFTER_DRAIN = false;
    const bf16_t* gl; const float* gate_b; int goff; float* m32; bf16_t* merged;
    __device__ __forceinline__ void operator()(const f32x4 (&acc)[2][2][4][2], const Unit& u, int wr, int wc, int fr, int fq) const {
        const int row0 = u.pm * BM + wr * 64 + fr, col0 = u.pn * BM + wc * 32 + 8 * fq;
#pragma unroll
        for (int bj = 0; bj < 2; ++bj) { const int col = col0 + bj * HALF;
            const f32x4 b0 = *(const f32x4*)(gate_b + goff + col), b1 = *(const f32x4*)(gate_b + goff + col + 4);
#pragma unroll
            for (int ai = 0; ai < 2; ++ai)
#pragma unroll
                for (int m = 0; m < 4; ++m) { const size_t row = (size_t)(row0 + ai * HALF + m * 16);
                    const u32x4 gw = *(const u32x4*)(gl + row * 3072 + goff + col);
                    f32x4 g0, g1; g0[0] = __uint_as_float(gw.x << 16); g0[1] = __uint_as_float(gw.x & 0xffff0000u); g0[2] = __uint_as_float(gw.y << 16); g0[3] = __uint_as_float(gw.y & 0xffff0000u);
                    g1[0] = __uint_as_float(gw.z << 16); g1[1] = __uint_as_float(gw.z & 0xffff0000u); g1[2] = __uint_as_float(gw.w << 16); g1[3] = __uint_as_float(gw.w & 0xffff0000u);
                    g0 += b0; g1 += b1;
#pragma unroll
                    for (int j = 0; j < 4; ++j) { g0[j] = sigm(g0[j]); g1[j] = sigm(g1[j]); }
                    f32x4 v0 = acc[ai][bj][m][0] * g0, v1 = acc[ai][bj][m][1] * g1;
                    float* mp = m32 + row * 1024 + col;
                    if (MODE >= 1) { v0 += *(const f32x4*)mp; v1 += *(const f32x4*)(mp + 4); }
                    if (MODE <= 1) { *(f32x4*)mp = v0; *(f32x4*)(mp + 4) = v1; }
                    else store8(merged + row * 1024 + col, v0, v1); } }
    }
};
struct EpiRes {
    static constexpr bool PERM = false, AFTER_DRAIN = false;
    const float* x; float* x1;
    __device__ __forceinline__ void operator()(const f32x4 (&acc)[2][2][4][2], const Unit& u, int wr, int wc, int fr, int fq) const {
        const int row0 = u.pm * BM + wr * 64 + fr, col0 = u.pn * BM + wc * 32 + 4 * fq;
#pragma unroll
        for (int ai = 0; ai < 2; ++ai)
#pragma unroll
            for (int m = 0; m < 4; ++m) { const size_t off = (size_t)(row0 + ai * HALF + m * 16) * 1024 + col0;
#pragma unroll
                for (int bj = 0; bj < 2; ++bj)
#pragma unroll
                    for (int n = 0; n < 2; ++n) *(f32x4*)(x1 + off + bj * HALF + n * 16) = *(const f32x4*)(x + off + bj * HALF + n * 16) + acc[ai][bj][m][n]; }
    }
};

struct MoeOrder {
    const PG8_LAS int* tab; int nrb, ntn, G, c; const int* list; const unsigned* cnt;
    __device__ __forceinline__ bool next(int i, Unit& u) const {
        const int L = i * G + c; if (L >= nrb * ntn) return false;
        const int rb = L / ntn, ct = L - rb * ntn, tv = __builtin_amdgcn_readfirstlane(tab[rb]);
        u.pm = rb; u.pn = (tv & 255) * ntn + ct; return true; }
    __device__ __forceinline__ int a_tok(const Unit& u, int row) const {
        const int tv = __builtin_amdgcn_readfirstlane(tab[u.pm]), e = tv & 255, r = (tv >> 8) * 256 + row;
        return r < (int)cnt[e] ? (list[e * T + r] >> 1) : 0; }
    __device__ __forceinline__ void a_ready(const Unit&) const {}
    __device__ __forceinline__ void done(const Unit&) const {}
};
struct EpiMoeUp {
    static constexpr bool PERM = true, AFTER_DRAIN = false;
    bf16_t* hmid; const int* list; const unsigned* cnt; const float* rs2; const PG8_LAS int* tab;
    __device__ __forceinline__ void operator()(const f32x4 (&acc)[2][2][4][2], const Unit& u, int wr, int wc, int fr, int fq) const {
        const int tv = __builtin_amdgcn_readfirstlane(tab[u.pm]), e = tv & 255, base = (tv >> 8) * 256, ce = (int)cnt[e]; const int* le = list + e * T + base;
        const int row0 = u.pm * BM + wr * 64 + fr, hc0 = ((u.pn & 1) * BM + wc * 32 + 8 * fq) >> 1;
#pragma unroll
        for (int ai = 0; ai < 2; ++ai)
#pragma unroll
            for (int m = 0; m < 4; ++m) { const int r = wr * 64 + ai * HALF + m * 16 + fr; const float rs = rs2[(base + r < ce) ? (le[r] >> 1) : 0];
#pragma unroll
                for (int bj = 0; bj < 2; ++bj) { const f32x4 gt = acc[ai][bj][m][0] * rs, up = acc[ai][bj][m][1] * rs; u32x2 o;
                    o.x = cvt_pk_bf16(gt[0] * sigm(gt[0]) * up[0], gt[1] * sigm(gt[1]) * up[1]); o.y = cvt_pk_bf16(gt[2] * sigm(gt[2]) * up[2], gt[3] * sigm(gt[3]) * up[3]);
                    *(u32x2*)(hmid + (size_t)(row0 + ai * HALF + m * 16) * 256 + hc0 + bj * 64) = o; } }
    }
};
struct EpiMoeDown {
    static constexpr bool PERM = true, AFTER_DRAIN = false;
    bf16_t* yslot; const int* list; const unsigned* cnt; const float* aw; const PG8_LAS int* tab;
    __device__ __forceinline__ void operator()(const f32x4 (&acc)[2][2][4][2], const Unit& u, int wr, int wc, int fr, int fq) const {
        const int tv = __builtin_amdgcn_readfirstlane(tab[u.pm]), e = tv & 255, base = (tv >> 8) * 256, ce = (int)cnt[e];
        const int col0 = (u.pn & 3) * BM + wc * 32 + 8 * fq; const int* le = list + e * T + base;
#pragma unroll
        for (int ai = 0; ai < 2; ++ai)
#pragma unroll
            for (int m = 0; m < 4; ++m) { const int r = wr * 64 + ai * HALF + m * 16 + fr;
                if (base + r < ce) { const int a = le[r]; const float w = aw[a];
#pragma unroll
                    for (int bj = 0; bj < 2; ++bj) store8(yslot + (size_t)a * 1024 + col0 + bj * HALF, acc[ai][bj][m][0] * w, acc[ai][bj][m][1] * w); } }
    }
};
}


namespace fa {
typedef short bf16x8 __attribute__((ext_vector_type(8)));
typedef short s16x4 __attribute__((ext_vector_type(4)));
typedef float f32x16 __attribute__((ext_vector_type(16)));
typedef unsigned u32x4 __attribute__((ext_vector_type(4)));
__device__ __forceinline__ int crow(int r, int hi) { return (r & 3) + 8 * (r >> 2) + 4 * hi; }
__device__ __forceinline__ unsigned cvtpk(float lo, float hi) { unsigned r; asm volatile("v_cvt_pk_bf16_f32 %0, %1, %2" : "=v"(r) : "v"(lo), "v"(hi)); return r; }
__device__ __forceinline__ int v_rd_base(int lane) { return ((lane & 3) << 3) | (((lane >> 2) & 3) << 6) | (((lane >> 4) & 1) << 5) | (((lane >> 5) & 1) << 8); }
constexpr int v_rd_off(int d0, int ks, int half) { return d0 * 512 + ks * 4096 + half * 2048; }
template <int OFF> __device__ __forceinline__ s16x4 tr_read(int vb) { s16x4 r; asm volatile("ds_read_b64_tr_b16 %0, %1 offset:%2" : "=&v"(r) : "v"(vb), "i"(OFF) : "memory"); return r; }
template <int D0> __device__ __forceinline__ void pv_one(f32x16& od, int vb, bf16x8 pa0, bf16x8 pa1, bf16x8 pa2, bf16x8 pa3) {
    const s16x4 l0 = tr_read<v_rd_off(D0, 0, 0)>(vb), h0 = tr_read<v_rd_off(D0, 0, 1)>(vb), l1 = tr_read<v_rd_off(D0, 1, 0)>(vb), h1 = tr_read<v_rd_off(D0, 1, 1)>(vb);
    const s16x4 l2 = tr_read<v_rd_off(D0, 2, 0)>(vb), h2 = tr_read<v_rd_off(D0, 2, 1)>(vb), l3 = tr_read<v_rd_off(D0, 3, 0)>(vb), h3 = tr_read<v_rd_off(D0, 3, 1)>(vb);
    asm volatile("s_waitcnt lgkmcnt(0)" ::: "memory"); __builtin_amdgcn_sched_barrier(0);
#define FA_PK(L, H) (bf16x8){L[0], L[1], L[2], L[3], H[0], H[1], H[2], H[3]}
    od = __builtin_amdgcn_mfma_f32_32x32x16_bf16(pa0, FA_PK(l0, h0), od, 0, 0, 0);
    od = __builtin_amdgcn_mfma_f32_32x32x16_bf16(pa1, FA_PK(l1, h1), od, 0, 0, 0);
    od = __builtin_amdgcn_mfma_f32_32x32x16_bf16(pa2, FA_PK(l2, h2), od, 0, 0, 0);
    od = __builtin_amdgcn_mfma_f32_32x32x16_bf16(pa3, FA_PK(l3, h3), od, 0, 0, 0);
#undef FA_PK
}
template <int NQ, bool CAUSAL>
__device__ __forceinline__ void attn_block(bool do_store, const bf16* Qa, int ldqa, const bf16* Qb, int ldqb, const bf16* Ka, int ldka, const bf16* Kb, int ldkb,
                                           const bf16* V, int ldv, bf16* O, int ldo, int P0, int nkeys, LAS unsigned char* lds) {
    constexpr int KROWB = NQ * 32, SHM_K = 64 * KROWB, SHM_V = 64 * 256, NKI = SHM_K / 8192, NVI = 2;
    const int tid = threadIdx.x, wid = __builtin_amdgcn_readfirstlane(tid >> 6), lane = tid & 63, r32 = lane & 31, hi = lane >> 5;
    LAS unsigned char* K_lds = lds; LAS unsigned char* V_lds = lds + 2 * SHM_K;
    LAS float* wsf = (LAS float*)(lds + 2 * SHM_K + 2 * SHM_V) + wid * 64; LAS float* li_l = wsf; LAS float* al_l = wsf + 32;
    bf16x8 qr[NQ];
    { const bf16* qa = Qa + (size_t)(wid * 32 + r32) * ldqa + hi * 8;
#pragma unroll
      for (int d0 = 0; d0 < 8; ++d0) qr[d0] = *(const bf16x8*)(qa + d0 * 16);
      if constexpr (NQ == 12) { const bf16* qb = Qb + (size_t)(wid * 32 + r32) * ldqb + hi * 8;
#pragma unroll
          for (int d0 = 0; d0 < 4; ++d0) qr[8 + d0] = *(const bf16x8*)(qb + d0 * 16); } }
    const int NT = CAUSAL ? (P0 + 256) / 64 : nkeys / 64;
    const unsigned ldsw = (unsigned)wid * 1024u;
#define FA_ISSUE(t_, buf_) do { const size_t kb_ = (size_t)(t_) * 64; int tid_ = threadIdx.x; asm volatile("" : "+v"(tid_));   \
        _Pragma("unroll") for (int i_ = 0; i_ < NKI; ++i_) { const int pch_ = i_ * 512 + tid_, row_ = pch_ / (NQ * 2), cc_ = pch_ % (NQ * 2), sc_ = (cc_ & ~7) | ((cc_ & 7) ^ (row_ & 7)); \
            const bf16* src_ = ((NQ == 12) && sc_ >= 16) ? Kb + (kb_ + row_) * ldkb + (sc_ - 16) * 8 : Ka + (kb_ + row_) * ldka + sc_ * 8; \
            __builtin_amdgcn_global_load_lds((const unsigned*)src_, (LAS unsigned*)(K_lds + (buf_) * SHM_K + i_ * 8192 + ldsw), 16, 0, 0); } \
        _Pragma("unroll") for (int i_ = 0; i_ < NVI; ++i_) { const int byte_ = (i_ * 512 + tid_) * 16, sub_ = byte_ >> 9, within_ = byte_ & 511, kk_ = (sub_ >> 2) * 8 + (within_ >> 6), c_ = (sub_ & 3) * 32 + ((within_ & 63) >> 1); \
            const int k_ = (kk_ & ~0xC) | ((kk_ & 4) << 1) | ((kk_ & 8) >> 1); \
            __builtin_amdgcn_global_load_lds((const unsigned*)(V + (kb_ + k_) * ldv + c_), (LAS unsigned*)(V_lds + (buf_) * SHM_V + i_ * 8192 + ldsw), 16, 0, 0); } } while (0)
    float m_reg = -1e30f, l_reg = 0.f; f32x16 o[4];
#pragma unroll
    for (int d = 0; d < 4; ++d)
#pragma unroll
        for (int r = 0; r < 16; ++r) o[d][r] = 0.f;
    const int kbase_lane = KROWB * r32 + ((hi * 16) ^ ((r32 & 7) << 4));
    const int vb0 = (int)(unsigned)(size_t)(V_lds) + v_rd_base(lane);
    const int qpos = P0 + wid * 32 + r32;
    FA_ISSUE(0, 0);
    __syncthreads();
    for (int t = 0; t < NT; ++t) {
        const int buf = t & 1;
        if (t + 1 < NT) FA_ISSUE(t + 1, buf ^ 1);
        f32x16 p0, p1;
#pragma unroll
        for (int r = 0; r < 16; ++r) { p0[r] = 0.f; p1[r] = 0.f; }
        { LAS unsigned char* kt = K_lds + buf * SHM_K;
#pragma unroll
          for (int d0 = 0; d0 < NQ; ++d0) {
              const int off = (((d0 * 2) & ~7) << 4) + ((((d0 * 2) & 7) << 4 | (hi << 4)) ^ ((r32 & 7) << 4));
              const bf16x8 b0 = *(const LAS bf16x8*)(kt + KROWB * r32 + off), b1 = *(const LAS bf16x8*)(kt + KROWB * (32 + r32) + off);
              p0 = __builtin_amdgcn_mfma_f32_32x32x16_bf16(b0, qr[d0], p0, 0, 0, 0);
              p1 = __builtin_amdgcn_mfma_f32_32x32x16_bf16(b1, qr[d0], p1, 0, 0, 0); } }
        if (CAUSAL && t * 64 + 63 > P0 + wid * 32) {
            const int dq = qpos - t * 64 - 4 * hi; const float NEG = -__builtin_inff();
#pragma unroll
            for (int r = 0; r < 16; ++r) { const int c = (r & 3) + 8 * (r >> 2); if (dq - c < 0) p0[r] = NEG; if (dq - c - 32 < 0) p1[r] = NEG; }
        }
        float pmax = p0[0];
#pragma unroll
        for (int r = 1; r < 16; ++r) pmax = fmaxf(pmax, p0[r]);
#pragma unroll
        for (int r = 0; r < 16; ++r) pmax = fmaxf(pmax, p1[r]);
        { auto rr = __builtin_amdgcn_permlane32_swap(__float_as_uint(pmax), __float_as_uint(pmax), false, false); pmax = fmaxf(__uint_as_float(rr[0]), __uint_as_float(rr[1])); }
        float alpha = 1.f;
        if (!__all(pmax - m_reg <= 11.0f)) { const float mn = fmaxf(m_reg, pmax); alpha = __builtin_amdgcn_exp2f(m_reg - mn); m_reg = mn; }
        float ps = 0.f;
#pragma unroll
        for (int r = 0; r < 16; ++r) { p0[r] = __builtin_amdgcn_exp2f(p0[r] - m_reg); p1[r] = __builtin_amdgcn_exp2f(p1[r] - m_reg); ps += p0[r] + p1[r]; }
        { auto rr = __builtin_amdgcn_permlane32_swap(__float_as_uint(ps), __float_as_uint(ps), false, false); ps = __uint_as_float(rr[0]) + __uint_as_float(rr[1]); }
        l_reg = l_reg * alpha + ps;
        if (__any(alpha < 1.f)) { if (hi == 0) al_l[r32] = alpha; asm volatile("s_waitcnt lgkmcnt(0)" ::: "memory");
#pragma unroll
            for (int d = 0; d < 4; ++d)
#pragma unroll
                for (int r = 0; r < 16; ++r) o[d][r] *= al_l[crow(r, hi)];
            asm volatile("s_waitcnt lgkmcnt(0)" ::: "memory"); }
        bf16x8 pa0, pa1, pa2, pa3;
#define FA_PK4(P, B_, OUT) do { unsigned a0 = cvtpk(P[B_ + 0], P[B_ + 1]), a1 = cvtpk(P[B_ + 2], P[B_ + 3]); unsigned b0 = cvtpk(P[B_ + 4], P[B_ + 5]), b1 = cvtpk(P[B_ + 6], P[B_ + 7]); \
        auto r0 = __builtin_amdgcn_permlane32_swap(a0, b0, false, false); auto r1 = __builtin_amdgcn_permlane32_swap(a1, b1, false, false); \
        u32x4 w = {r0[0], r1[0], r0[1], r1[1]}; OUT = *reinterpret_cast<bf16x8*>(&w); } while (0)
        FA_PK4(p0, 0, pa0); FA_PK4(p0, 8, pa1); FA_PK4(p1, 0, pa2); FA_PK4(p1, 8, pa3);
#undef FA_PK4
        { const int vb = vb0 + buf * SHM_V;
          pv_one<0>(o[0], vb, pa0, pa1, pa2, pa3); pv_one<1>(o[1], vb, pa0, pa1, pa2, pa3); pv_one<2>(o[2], vb, pa0, pa1, pa2, pa3); pv_one<3>(o[3], vb, pa0, pa1, pa2, pa3); }
        __syncthreads();
    }
#undef FA_ISSUE
    if (hi == 0) li_l[r32] = l_reg; asm volatile("s_waitcnt lgkmcnt(0)" ::: "memory");
    bf16* Ow = O + (size_t)(wid * 32) * ldo;
#pragma unroll
    for (int r = 0; r < 16; ++r) { const int orow = crow(r, hi); const float rl = __builtin_amdgcn_rcpf(li_l[orow]);
#pragma unroll
        for (int d0 = 0; d0 < 4; ++d0) { const float v = o[d0][r] * rl; const float vn = __shfl_xor(v, 1);
            if (do_store && (r32 & 1) == 0) *(unsigned*)(Ow + (size_t)orow * ldo + d0 * 32 + r32) = cvtpk(v, vn); } }
    __syncthreads();
    (void)kbase_lane;
}
}
template <class SrcCol, class KScale>
__device__ __forceinline__ void tr_item(const float* W, int ldw, int K, bf16* WT, LAS float* scr, int item, int nblk, int lane, SrcCol srccol, KScale ksc, float csc = 1.f) {
    const int kb = item / nblk, nb = item % nblk, k0 = 64 * kb, n0 = 32 * nb;
    const int sc_ = srccol(n0 + (lane & 31));
#pragma unroll 8
    for (int i = 0; i < 32; ++i) { const int kk = 2 * i + (lane >> 5); scr[kk * 33 + (lane & 31)] = sc_ >= 0 ? W[(size_t)(k0 + kk) * ldw + sc_] * ksc(k0 + kk) * csc : 0.f; }
    asm volatile("s_waitcnt lgkmcnt(0)" ::: "memory");
    const int c = lane & 7;
#pragma unroll
    for (int j = 0; j < 4; ++j) { const int n = (lane >> 3) + 8 * j; const LAS float* sp = scr + (8 * c) * 33 + n;
        pg8::u32x4 o; o.x = pg8::cvt_pk_bf16(sp[0 * 33], sp[1 * 33]); o.y = pg8::cvt_pk_bf16(sp[2 * 33], sp[3 * 33]); o.z = pg8::cvt_pk_bf16(sp[4 * 33], sp[5 * 33]); o.w = pg8::cvt_pk_bf16(sp[6 * 33], sp[7 * 33]);
        *(pg8::u32x4*)(WT + (size_t)(n0 + n) * K + k0 + 8 * c) = o; }
    asm volatile("s_waitcnt lgkmcnt(0)" ::: "memory");
}


__device__ __forceinline__ void tr_item_gu(const float* Wg, const float* Wu, bf16* WT, LAS float* scr, int item, int lane) {
    const int kb = item >> 4, nb = item & 15, k0 = 64 * kb, n0 = 32 * nb;
    const int np = n0 + (lane & 31), q = np >> 3, w = np & 7; const float* W = (w < 4 ? Wg : Wu) + 4 * q + (w & 3);
#pragma unroll 8
    for (int i = 0; i < 32; ++i) { const int kk = 2 * i + (lane >> 5); scr[kk * 33 + (lane & 31)] = W[(size_t)(k0 + kk) * 256]; }
    asm volatile("s_waitcnt lgkmcnt(0)" ::: "memory");
    const int c = lane & 7;
#pragma unroll
    for (int j = 0; j < 4; ++j) { const int n = (lane >> 3) + 8 * j; const LAS float* sp = scr + (8 * c) * 33 + n;
        pg8::u32x4 o; o.x = pg8::cvt_pk_bf16(sp[0 * 33], sp[1 * 33]); o.y = pg8::cvt_pk_bf16(sp[2 * 33], sp[3 * 33]); o.z = pg8::cvt_pk_bf16(sp[4 * 33], sp[5 * 33]); o.w = pg8::cvt_pk_bf16(sp[6 * 33], sp[7 * 33]);
        *(pg8::u32x4*)(WT + (size_t)(n0 + n) * 1024 + k0 + 8 * c) = o; }
    asm volatile("s_waitcnt lgkmcnt(0)" ::: "memory");
}
struct Args { const float* in[28]; float* out; unsigned char* ws; int ph_lo, ph_hi, li, pad; };

constexpr int LDS_BYTES = 155648;
constexpr int N_PHASES = 13;

__global__ void __launch_bounds__(NTHREADS, 2) fwd(Args args) {
    extern __shared__ __attribute__((aligned(16))) unsigned char lds_raw[];
    LAS unsigned char* lds = (LAS unsigned char*)lds_raw;
    LAS float* sm = (LAS float*)lds;
    LAS float* wsm = (LAS float*)(lds + 16384);
    volatile LAS unsigned* MISC = (volatile LAS unsigned*)(lds + MISC_OFF);
    const int tid = threadIdx.x, lane = tid & 63, wave = tid >> 6, G = gridDim.x;
    const int gw = blockIdx.x * NWAVES + wave, NGW = G * NWAVES;
    unsigned char* ws = args.ws;
    unsigned* ctl = (unsigned*)(ws + WS_CTL);
    if (tid < 32) MISC[tid] = 0u;
    __syncthreads();
    XcdBarrier bar = xcd_barrier_post(ctl + CW_BAR + args.li * XCD_BAR_WORDS, MISC + 8);
    const int lo = args.ph_lo, hi = args.ph_hi;
#define IN(k) (lo <= (k) && (k) < hi)
#ifndef PH_MASK
#define PH_MASK 0xffff
#endif
#define PHEN(k) (((PH_MASK) >> (k)) & 1)
#ifndef FASTMASK
#define FASTMASK 0xec
#endif
#define FAST(k) (((FASTMASK) >> (k)) & 1)
#ifndef PROBE_MASK
#define PROBE_MASK 0
#endif
#define NREP(k) ((((PROBE_MASK) >> (k)) & 1) ? 2 : 1)
#ifndef G1MASK
#define G1MASK 0x3f
#endif
#ifndef X2_DELAY_US
#define X2_DELAY_US 0
#define W1_TEST 0
#define DBL_BAR 1
#endif
#ifndef E6ORDER
#define E6ORDER 0
#endif
#define NG1(g) (E6ORDER || !FAST(0) || !(((G1MASK) >> (g)) & 1))
#define PH_LOCALS int tid = threadIdx.x; asm volatile("" : "+v"(tid)); const int lane = tid & 63, wave = __builtin_amdgcn_readfirstlane(tid >> 6), gw = blockIdx.x * NWAVES + wave; (void)lane; (void)gw;
#define SEAM(k) do { if (IN(k) && IN((k) + 1)) xcd_barrier(bar); } while (0)

#define xin (args.in[0])
#define memin (args.in[1])
#define mix_g (args.in[3])
#define w_in (args.in[4])
#define gate_b (args.in[5])
#define q_g (args.in[6])
#define w_uq (args.in[7])
#define kv_g (args.in[8])
#define w_uk (args.in[9])
#define w_uv (args.in[10])
#define pool_w (args.in[11])
#define pool_scale (args.in[12])
#define mem_g (args.in[13])
#define w_mem_kv (args.in[14])
#define w_br_pool (args.in[15])
#define w_br_mla (args.in[16])
#define w_br_mem (args.in[17])
#define w_out (args.in[18])
#define ffn_g (args.in[19])
#define w_rg (args.in[20])
#define b_rg (args.in[21])
#define w_re (args.in[22])
#define b_re (args.in[23])
#define w_gate_e (args.in[24])
#define w_up_e (args.in[25])
#define w_down_e (args.in[26])
#define final_g (args.in[27])
#define positions ((const int*)args.in[2])
#define ropeC ((float*)(ws + WS_ROPEC))
#define ropeS ((float*)(ws + WS_ROPES))
#define rsq ((float*)(ws + WS_RSQ))
#define rskv ((float*)(ws + WS_RSKV))
#define aw ((float*)(ws + WS_AW))
#define blockcnt ((int*)(ws + WS_BCNT))
#define erank ((int*)(ws + WS_ERANK))
#define rs2 ((float*)(ws + WS_RS2))
#define mkv ((bf16*)(ws + WS_MKV))
#define memn ((bf16*)(ws + WS_MEMN))
#define kr ((bf16*)(ws + WS_KR))
#define list ((int*)(ws + WS_LIST))
#define hb ((bf16*)(ws + WS_A))
#define qn ((bf16*)(ws + WS_A))
#define ymla ((bf16*)(ws + WS_A))
#define h2 ((bf16*)(ws + WS_A))
#define gates ((bf16*)(ws + WS_GATES))
#define hg ((float*)(ws + WS_HG))
#define hmid ((bf16*)(ws + WS_HMID))
#define pxq ((bf16*)(ws + WS_PXQ))
#define qkvd ((bf16*)(ws + WS_QKVD))
#define pp ((bf16*)(ws + WS_P))
#define qr ((bf16*)(ws + WS_QR))
#define merged ((bf16*)(ws + WS_MERGED))
#define yslot ((bf16*)(ws + WS_YSLOT))
#define kn ((bf16*)args.out)
#define vv ((bf16*)args.out + (size_t)T * D)
#define m32 (args.out)
#define x1 (args.out)
#define Wt_gu ((bf16*)(ws + WS_WGU))
#define Wt_d ((bf16*)(ws + WS_WD))
#define hmid2 ((bf16*)(ws + WS_HMID2))
#define Wt_in ((bf16*)(ws + WS_WIN))
#define Wt_uq ((bf16*)(ws + WS_WUQ))
#define Wt_ukv ((bf16*)(ws + WS_WUKV))
#define Wt_out ((bf16*)(ws + WS_WOUT))
#define Wt_brmla ((bf16*)(ws + WS_WBRMLA))
#define Wt_memkv ((bf16*)(ws + WS_WMEMKV))
#define Wt_brpool ((bf16*)(ws + WS_WBRPOOL))
#define Wt_brmem ((bf16*)(ws + WS_WBRMEM))
    unsigned* cnt = ctl + CW_CNT;
    int toff = 0;

    if (PHEN(0) && IN(0)) {
      for (int rep_ = 0; rep_ < NREP(0); ++rep_) {
        PH_LOCALS
        for (int r = gw; r < T + MROWS; r += NGW) {
            const bool is_x = r < T; const float* src = is_x ? xin + (size_t)r * D : memin + (size_t)(r - T) * D;
            const float* g = is_x ? mix_g : mem_g; bf16* dst = is_x ? hb + (size_t)r * D : memn + (size_t)(r - T) * D;
            float v[16]; float s = 0.f;
#pragma unroll
            for (int j = 0; j < 4; ++j) { const f32x4 q = *(const f32x4*)(src + j * 256 + lane * 4); v[4*j] = q[0]; v[4*j+1] = q[1]; v[4*j+2] = q[2]; v[4*j+3] = q[3]; s += q[0]*q[0] + q[1]*q[1] + q[2]*q[2] + q[3]*q[3]; }
            const float rs = 1.0f / sqrtf(wave_sum(s) * (1.f / D) + RMS_EPS);
#pragma unroll
            for (int j = 0; j < 4; ++j)
#pragma unroll
                for (int i = 0; i < 4; ++i) { const int c = j * 256 + lane * 4 + i; dst[c] = f2bf(v[4*j+i] * rs * g[c]); }
        }
        for (int i = blockIdx.x * NTHREADS + tid; i < T * 32; i += G * NTHREADS) {
            const int t = i >> 5, f = i & 31;
            const float invf = exp2f(-(float)(2 * f) * (13.287712379549449f / 64.0f));
            const float ang = (float)positions[t] * invf;
            float sn, cs; sincosf(ang, &sn, &cs);
            ropeC[i] = cs; ropeS[i] = sn;
        }
          }
    }
    if (PHEN(0) && IN(0)) {
      for (int rep_ = 0; rep_ < NREP(0); ++rep_) {
        PH_LOCALS
        LAS float* scr = (LAS float*)(lds + wave * 16384);
        constexpr int I_IN = 16 * (NPAD_IN / 32), I_UQ = 6 * 48, I_UKV = 4 * 64, I_SQ = 16 * 32, I_HALF = 8 * 32;
        constexpr int NIT = I_IN + I_UQ + I_UKV + 3 * I_SQ + 2 * I_HALF;
        auto one = [](int) { return 1.f; };
        for (int it = gw; it < NIT; it += NGW) {
            int r = it;
            if (r < I_IN) { const int nb = r % (NPAD_IN / 32);
                tr_item(w_in, DIN, 1024, Wt_in, scr, r, NPAD_IN / 32, lane, [](int n) {
                    if (n < 512) return n; if (n < 1024) return 1216 + (n - 512); if (n < 4096) return 1728 + (n - 1024); if (n < 4480) return 512 + (n - 4096);
                    if (n < 4736) return 896 + (n - 4480); if (n < 4800) return 1152 + (n - 4736); return -1; }, one, (nb >= 16 && nb < 32) ? QSCALE_MEM : 1.f); continue; } r -= I_IN;
            if (r < I_UQ) { const float* g = q_g; tr_item(w_uq, 1536, 384, Wt_uq, scr, r, 48, lane, [](int n) {
                    if (n < 1024) return (n >> 7) * 192 + (n & 127); const int q = n - 1024, hh = q >> 6, j = q & 63; return hh * 192 + 128 + (j >> 1) + 32 * (j & 1); }, [g](int k) { return g[k]; }); continue; } r -= I_UQ;
            if (r < I_UKV) { const float* g = kv_g; const int nb = r % 64;
                if (nb < 32) tr_item(w_uk, 1024, 256, Wt_ukv, scr, r, 64, lane, [](int n) { return n; }, [g](int k) { return g[k]; });
                else tr_item(w_uv - 1024, 1024, 256, Wt_ukv, scr, r, 64, lane, [](int n) { return n; }, [g](int k) { return g[k]; });
                continue; } r -= I_UKV;
            if (r < I_SQ) { tr_item(w_mem_kv, 1024, 1024, Wt_memkv, scr, r, 32, lane, [](int n) { return n; }, one); continue; } r -= I_SQ;
            if (r < I_SQ) { tr_item(w_br_mla, 1024, 1024, Wt_brmla, scr, r, 32, lane, [](int n) { return n; }, one); continue; } r -= I_SQ;
            if (r < I_SQ) { tr_item(w_out, 1024, 1024, Wt_out, scr, r, 32, lane, [](int n) { return n; }, one); continue; } r -= I_SQ;
            if (r < I_HALF) { if (!FAST(7)) tr_item(w_br_pool, 1024, 512, Wt_brpool, scr, r, 32, lane, [](int n) { return n; }, one); continue; } r -= I_HALF;
            tr_item(w_br_mem, 1024, 512, Wt_brmem, scr, r, 32, lane, [](int n) { return n; }, one);
        }
          }
    }
    if (PHEN(0) && IN(0) && FAST(7)) {
        __syncthreads();
        LAS float* As = (LAS float*)lds; LAS float* Bs = As + 128 * 64;
        const int tid = threadIdx.x, ty = tid >> 4, tx = tid & 15;
        for (int tile = (int)blockIdx.x; tile < 128; tile += G) {
            const int g = tile >> 5, c0 = ((tile >> 4) & 1) * 64, n0 = (tile & 15) * 64;
            for (int i = tid; i < 64 * 128; i += NTHREADS) { const int c = i >> 7, d = i & 127; As[d * 64 + c] = pool_w[(size_t)g * 16384 + (c0 + c) * 128 + d] * pool_scale[g * 128 + d]; }
            for (int i = tid; i < 128 * 64; i += NTHREADS) { const int d = i >> 6, n = i & 63; Bs[d * 64 + n] = w_br_pool[(size_t)(g * 128 + d) * 1024 + n0 + n]; }
            __syncthreads();
            float acc[2][4];
#pragma unroll
            for (int i = 0; i < 2; ++i)
#pragma unroll
                for (int j = 0; j < 4; ++j) acc[i][j] = 0.f;
#pragma unroll 8
            for (int d = 0; d < 128; ++d) { const float a0 = As[d * 64 + ty * 2], a1 = As[d * 64 + ty * 2 + 1]; const f32x4 bb = *(const LAS f32x4*)(Bs + d * 64 + tx * 4);
#pragma unroll
                for (int j = 0; j < 4; ++j) { acc[0][j] += a0 * bb[j]; acc[1][j] += a1 * bb[j]; } }
#pragma unroll
            for (int i = 0; i < 2; ++i)
#pragma unroll
                for (int j = 0; j < 4; ++j) Wt_brpool[(size_t)(n0 + tx * 4 + j) * 512 + g * 128 + c0 + ty * 2 + i] = f2bf(acc[i][j]);
            __syncthreads();
        }
    }
    SEAM(0);
#if defined(X2_DELAY_US) && X2_DELAY_US > 0
    { const unsigned long long t0 = __builtin_amdgcn_s_memrealtime(); while (__builtin_amdgcn_s_memrealtime() - t0 < (unsigned long long)X2_DELAY_US * 100ull) __builtin_amdgcn_s_sleep(16); }
    __syncthreads();
#endif
    if (PHEN(1) && IN(1)) {
      for (int rep_ = 0; rep_ < NREP(1); ++rep_) {
        PH_LOCALS
        { pg8::Gemm g{hb, Wt_in, T, NPAD_IN, 1024, 1024, 1024}; pg8::StaticOrder So; So.init(T, NPAD_IN, G, (int)blockIdx.x);
          pg8::EpiStore3 E{pxq, gates, qkvd};
          pg8::gemm_phase<pg8::EpiStore3, pg8::StaticOrder, PG8_ALIGN, PG8_SP2>(lds, g, So, E); }
        { pg8::Gemm g{memn, Wt_memkv, MROWS, 1024, 1024, 1024, 1024}; pg8::StaticOrder So; So.init(MROWS, 1024, G, ((int)blockIdx.x + G - 192) % G);
          pg8::EpiStore E{mkv, 1024};
          pg8::gemm_phase<pg8::EpiStore, pg8::StaticOrder, PG8_ALIGN, PG8_SP2>(lds, g, So, E); }
          }
    }
    SEAM(1);
#if defined(XBARS)
    for (int i_ = 0; i_ < XBARS; ++i_) xcd_barrier(bar);
#endif
    if (PHEN(2) && IN(2)) {
        PH_LOCALS
        for (int t = gw; t < T; t += NGW) {
            const bf16* qk = qkvd + (size_t)t * 768;
            const uint4 c0 = *(const uint4*)(qk + lane * 8);
            const uint4 c1 = (lane < 24) ? *(const uint4*)(qk + (64 + lane) * 8) : make_uint4(0u, 0u, 0u, 0u);
            float f0[8], f1[8];
            { const unsigned w0[4] = {c0.x, c0.y, c0.z, c0.w}, w1[4] = {c1.x, c1.y, c1.z, c1.w};
#pragma unroll
              for (int i = 0; i < 4; ++i) { f0[2 * i] = __uint_as_float(w0[i] << 16); f0[2 * i + 1] = __uint_as_float(w0[i] & 0xffff0000u); f1[2 * i] = __uint_as_float(w1[i] << 16); f1[2 * i + 1] = __uint_as_float(w1[i] & 0xffff0000u); } }
            float q0 = 0.f, q1 = 0.f;
#pragma unroll
            for (int i = 0; i < 8; ++i) { q0 += f0[i] * f0[i]; q1 += f1[i] * f1[i]; }
            const float s1 = wave_sum(lane < 48 ? q0 : 0.f);
            const float s2 = wave_sum((lane >= 48 ? q0 : 0.f) + (lane < 16 ? q1 : 0.f));
            if (lane == 0) { rsq[t] = 1.0f / sqrtf(s1 * (1.f / 384.f) + RMS_EPS); rskv[t] = 1.0f / sqrtf(s2 * (1.f / 256.f) + RMS_EPS); }
            { float o8[8];
#pragma unroll
              for (int i = 0; i < 8; ++i) o8[i] = __shfl_xor(f1[i], 4);
              if (lane >= 16 && lane < 24) { const bool isx1 = lane < 20; const int j = (lane - 16) & 3;
                  const f32x4 ca = *(const f32x4*)(ropeC + (size_t)t * 32 + 8 * j), cb = *(const f32x4*)(ropeC + (size_t)t * 32 + 8 * j + 4);
                  const f32x4 sa = *(const f32x4*)(ropeS + (size_t)t * 32 + 8 * j), sb = *(const f32x4*)(ropeS + (size_t)t * 32 + 8 * j + 4);
                  const float cc[8] = {ca[0], ca[1], ca[2], ca[3], cb[0], cb[1], cb[2], cb[3]}, sn[8] = {sa[0], sa[1], sa[2], sa[3], sb[0], sb[1], sb[2], sb[3]};
                  float r8[8];
#pragma unroll
                  for (int i = 0; i < 8; ++i) r8[i] = isx1 ? (f1[i] * cc[i] - o8[i] * sn[i]) : (f1[i] * cc[i] + o8[i] * sn[i]);
                  pg8::u32x4 w; w.x = pg8::cvt_pk_bf16(r8[0], r8[1]); w.y = pg8::cvt_pk_bf16(r8[2], r8[3]); w.z = pg8::cvt_pk_bf16(r8[4], r8[5]); w.w = pg8::cvt_pk_bf16(r8[6], r8[7]);
                  *(pg8::u32x4*)(kr + (size_t)t * 64 + (isx1 ? 0 : 32) + 8 * j) = w; } }
            { const int sidx = t & (S - 1), g = lane >> 4, w = 2 << g, n = (sidx + 1 < w) ? sidx + 1 : w;
              const bf16* up = pxq + (size_t)t * 1024 + lane * 8;
              float acc8[8];
#pragma unroll
              for (int i = 0; i < 8; ++i) acc8[i] = 0.f;
              float cur[8];
              for (int i = 0; i < n; ++i) { const uint4 u4 = *(const uint4*)(up - (size_t)i * 1024); const unsigned ww[4] = {u4.x, u4.y, u4.z, u4.w};
#pragma unroll
                  for (int k = 0; k < 4; ++k) { const float lo = __uint_as_float(ww[k] << 16), hi_ = __uint_as_float(ww[k] & 0xffff0000u); acc8[2 * k] += lo; acc8[2 * k + 1] += hi_; if (i == 0) { cur[2 * k] = lo; cur[2 * k + 1] = hi_; } } }
              const float inv = 1.f / (float)n;
              pg8::u32x4 o; o.x = pg8::cvt_pk_bf16(acc8[0] * inv - cur[0], acc8[1] * inv - cur[1]); o.y = pg8::cvt_pk_bf16(acc8[2] * inv - cur[2], acc8[3] * inv - cur[3]);
              o.z = pg8::cvt_pk_bf16(acc8[4] * inv - cur[4], acc8[5] * inv - cur[5]); o.w = pg8::cvt_pk_bf16(acc8[6] * inv - cur[6], acc8[7] * inv - cur[7]);
              *(pg8::u32x4*)(pp + (size_t)t * 512 + lane * 8) = o; }
        }
    }
    SEAM(2);
    if (PHEN(3) && IN(3)) {
      for (int rep_ = 0; rep_ < NREP(3); ++rep_) {
        PH_LOCALS
        { pg8::Gemm g{qkvd, Wt_uq, T, 1536, 384, 768, 384}; pg8::StaticOrder So; So.init(T, 1536, G, (int)blockIdx.x);
          pg8::EpiQ E{qn, qr, rsq, ropeC, ropeS};
          pg8::gemm_phase<pg8::EpiQ, pg8::StaticOrder, PG8_ALIGN, PG8_SP2>(lds, g, So, E); }
        { pg8::Gemm g{qkvd + 384, Wt_ukv, T, 2048, 256, 768, 256}; pg8::StaticOrder So; So.init(T, 2048, G, G - 1 - (int)blockIdx.x);
          pg8::EpiKV E{kn, vv, rskv};
          pg8::gemm_phase<pg8::EpiKV, pg8::StaticOrder, PG8_ALIGN, PG8_SP2>(lds, g, So, E); }
          }
    }
    SEAM(3);
    if (PHEN(5) && IN(5) && FAST(5)) {
      for (int rep_ = 0; rep_ < NREP(5); ++rep_) {
        for (int L = (int)blockIdx.x; L < 256; L += G) {
            const int bh = L >> 3, x = L & 7, b = bh >> 3, h = bh & 7;
#pragma unroll 1
            for (int pass = 0; pass < 2; ++pass) {
                const int qb = pass ? x : 15 - x; const size_t row0 = (size_t)b * S + (size_t)qb * 256, k0 = (size_t)b * S;
                fa::attn_block<12, true>(rep_ == NREP(5) - 1, qn + row0 * 1024 + h * 128, 1024, qr + row0 * 512 + h * 64, 512, kn + k0 * 1024 + h * 128, 1024, kr + k0 * 64, 64,
                                         vv + k0 * 1024 + h * 128, 1024, ymla + row0 * 1024 + h * 128, 1024, qb * 256, S, lds);
            }
        }
        for (int L = (int)blockIdx.x; L < 256; L += G) {
            const int b = L >> 6, h = (L >> 4) & 3, qb = L & 15; const size_t row0 = (size_t)b * S + (size_t)qb * 256, k0 = (size_t)b * MEMLEN;
            fa::attn_block<8, false>(rep_ == NREP(5) - 1, pxq + row0 * 1024 + 512 + h * 128, 1024, nullptr, 0, mkv + k0 * 1024 + h * 128, 1024, nullptr, 0,
                                     mkv + k0 * 1024 + 512 + h * 128, 1024, pxq + row0 * 1024 + 512 + h * 128, 1024, 0, MEMLEN, lds);
        }
          }
    }
    if (PHEN(5) && IN(5) && !FAST(5)) {
      for (int rep_ = 0; rep_ < NREP(5); ++rep_) {
        PH_LOCALS
        LAS float* qs = wsm + wave * 256;
        for (int task = gw; task < T * 8; task += NGW) {
            const int t = task >> 3, hh = task & 7, b = t >> 12, sidx = t & (S - 1);
            qs[lane] = bf2f(qn[(size_t)t * 1024 + hh * 128 + lane]); qs[64 + lane] = bf2f(qn[(size_t)t * 1024 + hh * 128 + 64 + lane]);
            qs[128 + lane] = bf2f(qr[(size_t)t * 512 + hh * 64 + lane]);
            asm volatile("s_waitcnt lgkmcnt(0)" ::: "memory");
            float m_run = -1e30f, l_run = 0.f, o0 = 0.f, o1 = 0.f;
            for (int j0 = 0; j0 <= sidx; j0 += 64) {
                asm volatile("" ::: "memory");
                const int key = j0 + lane; const bool valid = key <= sidx; const size_t kt = (size_t)(b * S + (valid ? key : sidx));
                float sc = 0.f;
                const bf16* kp = kn + kt * 1024 + hh * 128;
#pragma unroll 2
                for (int k = 0; k < 128; k += 8) { const uint4 w = *(const uint4*)(kp + k); const unsigned ww[4] = {w.x, w.y, w.z, w.w};
#pragma unroll
                    for (int i = 0; i < 4; ++i) { sc += qs[k + 2*i] * __uint_as_float(ww[i] << 16) + qs[k + 2*i + 1] * __uint_as_float(ww[i] & 0xffff0000u); } }
                const bf16* rp = kr + kt * 64;
#pragma unroll 2
                for (int k = 0; k < 64; k += 8) { const uint4 w = *(const uint4*)(rp + k); const unsigned ww[4] = {w.x, w.y, w.z, w.w};
#pragma unroll
                    for (int i = 0; i < 4; ++i) { sc += qs[128 + k + 2*i] * __uint_as_float(ww[i] << 16) + qs[128 + k + 2*i + 1] * __uint_as_float(ww[i] & 0xffff0000u); } }
                if (!valid) sc = -1e30f;
                const float mn = fmaxf(m_run, wave_max(sc));
                const float alpha = exp2f(m_run - mn);
                const float p = valid ? exp2f(sc - mn) : 0.f;
                l_run = l_run * alpha + wave_sum(p); o0 *= alpha; o1 *= alpha; m_run = mn;
                const int nk = (sidx - j0 + 1 < 64) ? sidx - j0 + 1 : 64;
                for (int j = 0; j < nk; ++j) {
                    const float pj = __shfl(p, j);
                    const unsigned w = *(const unsigned*)(vv + (size_t)(b * S + j0 + j) * 1024 + hh * 128 + lane * 2);
                    o0 += pj * __uint_as_float(w << 16); o1 += pj * __uint_as_float(w & 0xffff0000u);
                }
            }
            const float il = 1.f / l_run;
            *(unsigned*)(ymla + (size_t)t * 1024 + hh * 128 + lane * 2) = (unsigned)f2bf(o0 * il) | ((unsigned)f2bf(o1 * il) << 16);
        }
        for (int task = gw; task < T * 4; task += NGW) {
            const int t = task >> 2, hh = task & 3, b = t >> 12;
            qs[lane] = bf2f(pxq[(size_t)t * 1024 + 512 + hh * 128 + lane]); qs[64 + lane] = bf2f(pxq[(size_t)t * 1024 + 512 + hh * 128 + 64 + lane]);
            asm volatile("s_waitcnt lgkmcnt(0)" ::: "memory");
            float m_run = -1e30f, l_run = 0.f, o0 = 0.f, o1 = 0.f;
            for (int j0 = 0; j0 < MEMLEN; j0 += 64) {
                asm volatile("" ::: "memory");
                const size_t kt = (size_t)(b * MEMLEN + j0 + lane);
                float sc = 0.f;
                const bf16* kp = mkv + kt * 1024 + hh * 128;
#pragma unroll 2
                for (int k = 0; k < 128; k += 8) { const uint4 w = *(const uint4*)(kp + k); const unsigned ww[4] = {w.x, w.y, w.z, w.w};
#pragma unroll
                    for (int i = 0; i < 4; ++i) { sc += qs[k + 2*i] * __uint_as_float(ww[i] << 16) + qs[k + 2*i + 1] * __uint_as_float(ww[i] & 0xffff0000u); } }
                const float mn = fmaxf(m_run, wave_max(sc));
                const float alpha = exp2f(m_run - mn);
                const float p = exp2f(sc - mn);
                l_run = l_run * alpha + wave_sum(p); o0 *= alpha; o1 *= alpha; m_run = mn;
                for (int j = 0; j < 64; ++j) {
                    const float pj = __shfl(p, j);
                    const unsigned w = *(const unsigned*)(mkv + (size_t)(b * MEMLEN + j0 + j) * 1024 + 512 + hh * 128 + lane * 2);
                    o0 += pj * __uint_as_float(w << 16); o1 += pj * __uint_as_float(w & 0xffff0000u);
                }
            }
            const float il = 1.f / l_run;
            *(unsigned*)(pxq + (size_t)t * 1024 + 512 + hh * 128 + lane * 2) = (unsigned)f2bf(o0 * il) | ((unsigned)f2bf(o1 * il) << 16);
        }
          }
    }
    SEAM(5);
    if (PHEN(6) && IN(6) && !FAST(7)) {
      for (int rep_ = 0; rep_ < NREP(6); ++rep_) {
        PH_LOCALS
        for (int g = 0; g < 4; ++g)
            ngemm(sm, T, 128, 128, toff,
                  [&](int m, int k) { return bf2f(pp[(size_t)m * 512 + g * 128 + k]); },
                  [&](int k, int n) { return pool_w[(size_t)g * 16384 + k * 128 + n]; },
                  [&](int m, int n, float a) { pxq[(size_t)m * 1024 + g * 128 + n] = f2bf(a * pool_scale[g * 128 + n]); });
          }
    }
    if (!FAST(7)) SEAM(6);
    if (PHEN(7) && IN(7)) {
      for (int rep_ = 0; rep_ < NREP(7); ++rep_) {
        PH_LOCALS
        if (FAST(2)) {
        pg8::StaticOrder So; So.init(T, 1024, G, (int)blockIdx.x);
        { pg8::Gemm g{FAST(7) ? pp : pxq, Wt_brpool, T, 1024, 512, FAST(7) ? 512 : 1024, 512}; pg8::EpiGate<0> E{gates, gate_b, 0, m32, merged};
          pg8::gemm_phase<pg8::EpiGate<0>, pg8::StaticOrder, PG8_ALIGN, PG8_SP2>(lds, g, So, E); }
        { pg8::Gemm g{ymla, Wt_brmla, T, 1024, 1024, 1024, 1024}; pg8::EpiGate<1> E{gates, gate_b, 1024, m32, merged};
          pg8::gemm_phase<pg8::EpiGate<1>, pg8::StaticOrder, PG8_ALIGN, PG8_SP2>(lds, g, So, E); }
        { pg8::Gemm g{pxq + 512, Wt_brmem, T, 1024, 512, 1024, 512}; pg8::EpiGate<2> E{gates, gate_b, 2048, m32, merged};
          pg8::gemm_phase<pg8::EpiGate<2>, pg8::StaticOrder, PG8_ALIGN, PG8_SP2>(lds, g, So, E); }
        } else {
        auto gate = [&](int m, int j) { return 1.f / (1.f + __expf(-(bf2f(gates[(size_t)m * 3072 + j]) + gate_b[j]))); };
        int to = toff;
        ngemm(sm, T, D, 512, to,
              [&](int m, int k) { return bf2f(pxq[(size_t)m * 1024 + k]); },
              [&](int k, int n) { return w_br_pool[(size_t)k * D + n]; },
              [&](int m, int n, float a) { m32[(size_t)m * D + n] = a * gate(m, n); });
        to = toff;
        ngemm(sm, T, D, 1024, to,
              [&](int m, int k) { return bf2f(ymla[(size_t)m * 1024 + k]); },
              [&](int k, int n) { return w_br_mla[(size_t)k * D + n]; },
              [&](int m, int n, float a) { m32[(size_t)m * D + n] += a * gate(m, 1024 + n); });
        to = toff;
        ngemm(sm, T, D, 512, to,
              [&](int m, int k) { return bf2f(pxq[(size_t)m * 1024 + 512 + k]); },
              [&](int k, int n) { return w_br_mem[(size_t)k * D + n]; },
              [&](int m, int n, float a) { merged[(size_t)m * D + n] = f2bf(m32[(size_t)m * D + n] + a * gate(m, 2048 + n)); });
        toff = to;
        }
          }
    }
    SEAM(7);
    if (PHEN(8) && IN(8)) {
      for (int rep_ = 0; rep_ < NREP(8); ++rep_) {
        PH_LOCALS
        if (FAST(3)) {
        pg8::Gemm g{merged, Wt_out, T, 1024, 1024, 1024, 1024}; pg8::StaticOrder So; So.init(T, 1024, G, (int)blockIdx.x);
        pg8::EpiRes E{xin, x1};
        pg8::gemm_phase<pg8::EpiRes, pg8::StaticOrder, PG8_ALIGN, PG8_SP2>(lds, g, So, E);
        } else {
        ngemm(sm, T, D, D, toff,
              [&](int m, int k) { return bf2f(merged[(size_t)m * D + k]); },
              [&](int k, int n) { return w_out[(size_t)k * D + n]; },
              [&](int m, int n, float a) { x1[(size_t)m * D + n] = xin[(size_t)m * D + n] + a; });
        }
          }
    }
    SEAM(8);
    if (PHEN(9) && IN(9)) {
        const int tid = threadIdx.x, lane = tid & 63, wave = __builtin_amdgcn_readfirstlane(tid >> 6), r32 = lane & 31, hi = lane >> 5;
        LAS unsigned char* Whi = lds; LAS unsigned char* Wlo = lds + 73728; LAS float* gsm = (LAS float*)(lds + GSM_OFF); LAS int* lcnt = (LAS int*)(lds + LCNT_OFF);
        for (int k = tid; k < 1024; k += NTHREADS) { const float gk = ffn_g[k]; gsm[k] = gk;
            const f32x4 wg = *(const f32x4*)(w_rg + (size_t)k * 4);
#pragma unroll 4
            for (int c = 0; c < 36; ++c) {
                const int ex = ((c >> 2) & 1) * 16 + (c & 3) + 4 * (c >> 3);
                const float v = gk * (c < 32 ? w_re[(size_t)k * 32 + ex] : wg[c - 32]);
                const unsigned hb_ = f2bf(v); const unsigned lb_ = f2bf(v - __uint_as_float(hb_ << 16));
                const int off = c * 2048 + ((((k >> 3) ^ (c & 7))) << 4) + (k & 7) * 2;
                *(LAS unsigned short*)(Whi + off) = (unsigned short)hb_; *(LAS unsigned short*)(Wlo + off) = (unsigned short)lb_; } }
        if (tid < 32) lcnt[tid] = 0;
        __syncthreads();
        typedef short bf16x8 __attribute__((ext_vector_type(8))); typedef float f32x16 __attribute__((ext_vector_type(16)));
        for (int rep_ = 0; rep_ < NREP(14); ++rep_)
        for (int task = wave * G + (int)blockIdx.x; task < T / 32; task += NWAVES * G) {
            const int t = task * 32 + r32;
            const float* xr = x1 + (size_t)t * D + hi * 8; bf16* hr = h2 + (size_t)t * D + hi * 8;
            f32x16 p0, p1;
#pragma unroll
            for (int r = 0; r < 16; ++r) { p0[r] = 0.f; p1[r] = 0.f; }
            float ss = 0.f;
            const int rowA1 = (32 + r32 < 35) ? 32 + r32 : 35;
#pragma unroll 2
            for (int d0 = 0; d0 < 64; ++d0) {
                const f32x4 xa = *(const f32x4*)(xr + d0 * 16), xb = *(const f32x4*)(xr + d0 * 16 + 4);
                const f32x4 ga = *(const LAS f32x4*)(gsm + d0 * 16 + hi * 8), gb = *(const LAS f32x4*)(gsm + d0 * 16 + hi * 8 + 4);
                ss += (xa[0] * xa[0] + xa[1] * xa[1]) + (xa[2] * xa[2] + xa[3] * xa[3]) + (xb[0] * xb[0] + xb[1] * xb[1]) + (xb[2] * xb[2] + xb[3] * xb[3]);
                pg8::u32x4 hw; hw.x = pg8::cvt_pk_bf16(xa[0] * ga[0], xa[1] * ga[1]); hw.y = pg8::cvt_pk_bf16(xa[2] * ga[2], xa[3] * ga[3]); hw.z = pg8::cvt_pk_bf16(xb[0] * gb[0], xb[1] * gb[1]); hw.w = pg8::cvt_pk_bf16(xb[2] * gb[2], xb[3] * gb[3]);
                *(pg8::u32x4*)(hr + d0 * 16) = hw;
                pg8::u32x4 xh, xl; xh.x = pg8::cvt_pk_bf16(xa[0], xa[1]); xh.y = pg8::cvt_pk_bf16(xa[2], xa[3]); xh.z = pg8::cvt_pk_bf16(xb[0], xb[1]); xh.w = pg8::cvt_pk_bf16(xb[2], xb[3]);
                xl.x = pg8::cvt_pk_bf16(xa[0] - __uint_as_float(xh.x << 16), xa[1] - __uint_as_float(xh.x & 0xffff0000u)); xl.y = pg8::cvt_pk_bf16(xa[2] - __uint_as_float(xh.y << 16), xa[3] - __uint_as_float(xh.y & 0xffff0000u));
                xl.z = pg8::cvt_pk_bf16(xb[0] - __uint_as_float(xh.z << 16), xb[1] - __uint_as_float(xh.z & 0xffff0000u)); xl.w = pg8::cvt_pk_bf16(xb[2] - __uint_as_float(xh.w << 16), xb[3] - __uint_as_float(xh.w & 0xffff0000u));
                const bf16x8 bxh = *reinterpret_cast<bf16x8*>(&xh), bxl = *reinterpret_cast<bf16x8*>(&xl);
                const int ch = d0 * 2 + hi, o0 = r32 * 2048 + ((ch ^ (r32 & 7)) << 4), o1 = rowA1 * 2048 + ((ch ^ (rowA1 & 7)) << 4);
                const bf16x8 wh0 = *(const LAS bf16x8*)(Whi + o0), wl0 = *(const LAS bf16x8*)(Wlo + o0), wh1 = *(const LAS bf16x8*)(Whi + o1), wl1 = *(const LAS bf16x8*)(Wlo + o1);
                p0 = __builtin_amdgcn_mfma_f32_32x32x16_bf16(wh0, bxh, p0, 0, 0, 0); p0 = __builtin_amdgcn_mfma_f32_32x32x16_bf16(wl0, bxh, p0, 0, 0, 0); p0 = __builtin_amdgcn_mfma_f32_32x32x16_bf16(wh0, bxl, p0, 0, 0, 0);
                p1 = __builtin_amdgcn_mfma_f32_32x32x16_bf16(wh1, bxh, p1, 0, 0, 0); p1 = __builtin_amdgcn_mfma_f32_32x32x16_bf16(wl1, bxh, p1, 0, 0, 0); p1 = __builtin_amdgcn_mfma_f32_32x32x16_bf16(wh1, bxl, p1, 0, 0, 0);
            }
            { auto rr = __builtin_amdgcn_permlane32_swap(__float_as_uint(ss), __float_as_uint(ss), false, false); ss = __uint_as_float(rr[0]) + __uint_as_float(rr[1]); }
            const float rs = 1.0f / sqrtf(ss * (1.f / D) + RMS_EPS);
            float gl[4];
#pragma unroll
            for (int j = 0; j < 4; ++j) { auto rr = __builtin_amdgcn_permlane32_swap(__float_as_uint(p1[j]), __float_as_uint(p1[j]), false, false); gl[j] = __uint_as_float(rr[0]) * rs + b_rg[j]; }
            int gi = 0; float gmax = gl[0];
#pragma unroll
            for (int j = 1; j < 4; ++j) if (gl[j] > gmax) { gmax = gl[j]; gi = j; }
            float gden = 0.f;
#pragma unroll
            for (int j = 0; j < 4; ++j) gden += __expf(gl[j] - gmax);
            const float p_g = 1.f / gden;
            float el[8];
#pragma unroll
            for (int j = 0; j < 8; ++j) el[j] = ((gi & 1) ? p0[8 + j] : p0[j]) * rs + b_re[gi * 8 + j];
            int i1 = 0; float l1 = el[0];
#pragma unroll
            for (int j = 1; j < 8; ++j) if (el[j] > l1) { l1 = el[j]; i1 = j; }
            int i2 = -1; float l2 = -3.0e38f;
#pragma unroll
            for (int j = 0; j < 8; ++j) if (j != i1 && el[j] > l2) { l2 = el[j]; i2 = j; }
            const float rr_ = __expf(l2 - l1), w1 = p_g / (1.f + rr_), w2 = p_g * rr_ / (1.f + rr_);
            if ((gi >> 1) == hi && rep_ == NREP(14) - 1) {
                const int e1 = gi * 8 + i1, e2 = gi * 8 + i2;
                const int k1 = __hip_atomic_fetch_add(lcnt + e1, 1, __ATOMIC_RELAXED, __HIP_MEMORY_SCOPE_WORKGROUP), k2 = __hip_atomic_fetch_add(lcnt + e2, 1, __ATOMIC_RELAXED, __HIP_MEMORY_SCOPE_WORKGROUP);
                erank[2 * t] = e1 | (k1 << 8); erank[2 * t + 1] = e2 | (k2 << 8); aw[2 * t] = w1; aw[2 * t + 1] = w2; rs2[t] = rs;
            }
        }
        __syncthreads();
        if (tid < 32) blockcnt[(int)blockIdx.x * 32 + tid] = lcnt[tid];
    }
    if (IN(9)) xcd_barrier(bar);
    if (PHEN(9) && IN(9)) {
        const int tid = threadIdx.x; LAS int* offs = (LAS int*)(lds + OFFS_OFF);
        { LAS int* part = (LAS int*)lds;
          const int e = tid & 31, grp = tid >> 5, per = (G + 15) / 16; int o = 0, tot = 0;
          for (int b2 = grp * per; b2 < (grp + 1) * per && b2 < G; ++b2) { const int c = blockcnt[b2 * 32 + e]; tot += c; if (b2 < (int)blockIdx.x) o += c; }
          part[tid] = o; part[512 + tid] = tot;
          __syncthreads();
          if (tid < 32) { int oo = 0, tt = 0;
#pragma unroll
              for (int j = 0; j < 16; ++j) { oo += part[j * 32 + tid]; tt += part[512 + j * 32 + tid]; }
              offs[tid] = oo; if (blockIdx.x == 0) cnt[tid] = (unsigned)tt; } }
        __syncthreads();
        for (int wv = 0; wv < NWAVES; ++wv) for (int task = wv * G + (int)blockIdx.x; task < T / 32; task += NWAVES * G)
            if (tid < 64) { const int a = task * 64 + tid, er = erank[a], e = er & 255; list[e * T + offs[e] + (er >> 8)] = a; }
    }
    if (PHEN(9) && IN(9) && FAST(6)) {
        PH_LOCALS
        LAS float* scr = (LAS float*)(lds + wave * 16384);
        for (int rep_ = 0; rep_ < NREP(13); ++rep_)
        for (int it = gw; it < NE * 384; it += NGW) {
            const int e = it / 384, r = it - e * 384;
            if (r < 256) tr_item_gu(w_gate_e + (size_t)e * D * DE, w_up_e + (size_t)e * D * DE, Wt_gu + (size_t)e * 512 * 1024, scr, r, lane);
            else tr_item(w_down_e + (size_t)e * DE * D, 1024, 256, Wt_d + (size_t)e * 1024 * 256, scr, r - 256, 32, lane, [](int n) { return n; }, [](int) { return 1.f; });
        }
    }
    SEAM(9);
    if (FAST(6) && ((PHEN(10) && IN(10)) || (PHEN(11) && IN(11)))) {
        LAS int* tab = (LAS int*)(lds + TAB_OFF);
        if (threadIdx.x == 0) { int rb = 0; for (int e = 0; e < NE; ++e) { const int nb = ((int)cnt[e] + 255) >> 8; for (int k = 0; k < nb; ++k) tab[rb++] = e | (k << 8); } tab[191] = rb; }
        __syncthreads();
    }
    if (PHEN(10) && IN(10) && FAST(6)) {
      for (int rep_ = 0; rep_ < NREP(10); ++rep_) {
        const LAS int* tab = (const LAS int*)(lds + TAB_OFF); const int nrb = __builtin_amdgcn_readfirstlane(tab[191]);
        pg8::Gemm g{h2, Wt_gu, nrb * 256, NE * 512, 1024, 1024, 1024}; pg8::MoeOrder So{tab, nrb, 2, G, (int)blockIdx.x, list, cnt};
        pg8::EpiMoeUp E{hmid2, list, cnt, rs2, tab};
        pg8::gemm_phase_g<pg8::EpiMoeUp, pg8::MoeOrder>(lds, g, So, E);
          }
    }
    if (FAST(6)) SEAM(10);
    if (PHEN(11) && IN(11) && FAST(6)) {
      for (int rep_ = 0; rep_ < NREP(11); ++rep_) {
        const LAS int* tab = (const LAS int*)(lds + TAB_OFF); const int nrb = __builtin_amdgcn_readfirstlane(tab[191]);
        pg8::Gemm g{hmid2, Wt_d, nrb * 256, NE * 1024, 256, 256, 256}; pg8::MoeOrder So{tab, nrb, 4, G, (int)blockIdx.x, list, cnt};
        pg8::EpiMoeDown E{yslot, list, cnt, aw, tab};
        pg8::gemm_phase<pg8::EpiMoeDown, pg8::MoeOrder, PG8_ALIGN, PG8_SP2>(lds, g, So, E);
          }
    }
    if (FAST(6)) SEAM(11);
    if (PHEN(10) && IN(10) && !FAST(6)) {
      for (int rep_ = 0; rep_ < NREP(10); ++rep_) {
        PH_LOCALS
        int base = 0;
        for (int e = 0; e < NE; ++e) {
            const int ne = (int)cnt[e]; const int* le = list + e * T;
            const float* wg = w_gate_e + (size_t)e * D * DE; const float* wu = w_up_e + (size_t)e * D * DE;
            int to = toff;
            ngemm(sm, ne, DE, D, to,
                  [&](int m, int k) { return bf2f(h2[(size_t)(le[m] >> 1) * D + k]); },
                  [&](int k, int n) { return wg[(size_t)k * DE + n]; },
                  [&](int m, int n, float a) { hg[(size_t)(base + m) * DE + n] = a; });
            to = toff;
            ngemm(sm, ne, DE, D, to,
                  [&](int m, int k) { return bf2f(h2[(size_t)(le[m] >> 1) * D + k]); },
                  [&](int k, int n) { return wu[(size_t)k * DE + n]; },
                  [&](int m, int n, float a) { const float gg = hg[(size_t)(base + m) * DE + n]; hmid[(size_t)(base + m) * DE + n] = f2bf(gg / (1.f + __expf(-gg)) * a); });
            toff = to; base += ne;
        }
          }
    }
    if (!FAST(6)) SEAM(10);
    if (PHEN(11) && IN(11) && !FAST(6)) {
      for (int rep_ = 0; rep_ < NREP(11); ++rep_) {
        PH_LOCALS
        int base = 0;
        for (int e = 0; e < NE; ++e) {
            const int ne = (int)cnt[e]; const int* le = list + e * T;
            const float* wd = w_down_e + (size_t)e * DE * D;
            ngemm(sm, ne, D, DE, toff,
                  [&](int m, int k) { return bf2f(hmid[(size_t)(base + m) * DE + k]); },
                  [&](int k, int n) { return wd[(size_t)k * D + n]; },
                  [&](int m, int n, float a) { const int as = le[m]; yslot[(size_t)as * D + n] = f2bf(aw[as] * a); });
            base += ne;
        }
          }
    }
    if (!FAST(6)) SEAM(11);
    if (PHEN(12) && IN(12)) {
      for (int rep_ = 0; rep_ < NREP(12); ++rep_) {
        PH_LOCALS
        for (int t = gw; t < T; t += NGW) {
            float v[16]; float s = 0.f;
#pragma unroll
            for (int j = 0; j < 4; ++j) { const int c = j * 256 + lane * 4; const f32x4 q = *(const f32x4*)(x1 + (size_t)t * D + c);
                const uint2 y0 = *(const uint2*)(yslot + (size_t)(2 * t) * D + c), y1 = *(const uint2*)(yslot + (size_t)(2 * t + 1) * D + c);
                v[4*j]   = q[0] + __uint_as_float(y0.x << 16) + __uint_as_float(y1.x << 16);
                v[4*j+1] = q[1] + __uint_as_float(y0.x & 0xffff0000u) + __uint_as_float(y1.x & 0xffff0000u);
                v[4*j+2] = q[2] + __uint_as_float(y0.y << 16) + __uint_as_float(y1.y << 16);
                v[4*j+3] = q[3] + __uint_as_float(y0.y & 0xffff0000u) + __uint_as_float(y1.y & 0xffff0000u);
                s += v[4*j]*v[4*j] + v[4*j+1]*v[4*j+1] + v[4*j+2]*v[4*j+2] + v[4*j+3]*v[4*j+3]; }
            const float rs = 1.0f / sqrtf(wave_sum(s) * (1.f / D) + RMS_EPS);
#pragma unroll
            for (int j = 0; j < 4; ++j) { const int c = j * 256 + lane * 4; const f32x4 g = *(const f32x4*)(final_g + c);
                f32x4 o; o[0] = v[4*j] * rs * g[0]; o[1] = v[4*j+1] * rs * g[1]; o[2] = v[4*j+2] * rs * g[2]; o[3] = v[4*j+3] * rs * g[3];
                if (rep_ == NREP(12) - 1) *(f32x4*)(args.out + (size_t)t * D + c) = o; }
        }
          }
    }
#undef IN
#undef SEAM
}

extern "C" void kernel_launch(void* const* d_in, const int* in_sizes, int n_in, void* d_out, int out_size, void* d_ws, size_t ws_size, hipStream_t stream) {
    static int grid = 0;
    if (grid == 0) {
        if (n_in != 28 || out_size != T * D || ws_size < WS_END) { fprintf(stderr, "kernel_launch: unexpected shapes n_in %d out %d ws %zu\n", n_in, out_size, ws_size); grid = -1; return; }
        int dev = 0, cus = 0, per_cu = 0;
        if (hipGetDevice(&dev) != hipSuccess || hipDeviceGetAttribute(&cus, hipDeviceAttributeMultiprocessorCount, dev) != hipSuccess) { grid = -1; return; }
        if (hipFuncSetAttribute((const void*)fwd, hipFuncAttributeMaxDynamicSharedMemorySize, LDS_BYTES) != hipSuccess) { fprintf(stderr, "hipFuncSetAttribute failed\n"); grid = -1; return; }
        if (hipOccupancyMaxActiveBlocksPerMultiprocessor(&per_cu, (const void*)fwd, NTHREADS, LDS_BYTES) != hipSuccess || per_cu < 1) fprintf(stderr, "occupancy query: %d\n", per_cu);
        (void)hipGetLastError();
        grid = cus;
    }
    if (grid < 0) return;
    (void)hipMemsetAsync((char*)d_ws + WS_CTL, 0, CTL_ZERO_BYTES, stream);
    Args a{};
    for (int i = 0; i < 28; ++i) a.in[i] = (const float*)d_in[i];
    a.out = (float*)d_out; a.ws = (unsigned char*)d_ws; a.ph_lo = 0; a.ph_hi = N_PHASES;
#if defined(PROBE_SPLIT)
    a.ph_hi = PROBE_SPLIT + 1; a.li = 0;
    hipLaunchKernelGGL(fwd, dim3(grid), dim3(NTHREADS), LDS_BYTES, stream, a);
    a.ph_lo = PROBE_SPLIT; a.ph_hi = N_PHASES; a.li = 1;
#endif
    hipLaunchKernelGGL(fwd, dim3(grid), dim3(NTHREADS), LDS_BYTES, stream, a);
}
```
